# Optimizing an MI355X kernel written in HIP

```python
import functools
import jax, jax.numpy as jnp
from jax import lax
import numpy as np

D_MODEL = 2048
BATCH = 4
SEQ = 4096
DEPTH = 1
DEC_BATCH = 16
DEC_SEQ = 32
PAST_LEN = 1024

CHUNK = 64
LEFT_CHUNKS = 8
WINDOW = LEFT_CHUNKS * CHUNK
BAND = (LEFT_CHUNKS + 1) * CHUNK
HEAD_DIM = 128
D_A = D_MODEL // 2
N_HEADS_A = D_A // HEAD_DIM
D_M = D_MODEL // 4
N_HEADS_M = D_M // HEAD_DIM
N_MEM = 256
D_RNN = D_MODEL // 4
N_RNN_BLOCKS = 8
RNN_BLOCK = D_RNN // N_RNN_BLOCKS
CONV_B = 4
LRU_C = 8.0
D_FF = 3 * D_MODEL
CONV_F = 3
REL_CLIP = 256
EPS = 1e-6
D_MIX = D_A + D_M + D_RNN
D_IN = 3 * D_A + D_M + 2 * D_RNN
SPLITS = (D_A, 2 * D_A, 3 * D_A, 3 * D_A + D_M, 3 * D_A + D_M + D_RNN)
NEG = -1e30

kernel_name = 'hybrid_stream_chunk_encoder'


def rmsnorm(x, g):
    xf = x.astype(jnp.float32)
    y = xf * lax.rsqrt(jnp.mean(xf * xf, axis=-1, keepdims=True) + EPS)
    return (y * g.astype(jnp.float32)).astype(x.dtype)


def causal_dwconv(x, past, w, b):
    width = w.shape[0]
    t = x.shape[1]
    xp = jnp.concatenate([past, x], axis=1)
    y = b
    for k in range(width):
        y = y + w[k] * xp[:, k:k + t]
    return y, xp[:, -(width - 1):]


def softmax_attend(q, k, v, bias):
    s = jnp.einsum('...qhd,...khd->...hqk', q, k).astype(jnp.float32) * (HEAD_DIM ** -0.5) + bias
    p = jax.nn.softmax(s, axis=-1)
    return jnp.einsum('...hqk,...khd->...qhd', p.astype(v.dtype), v)


def rel_bias(table, dist):
    idx = jnp.clip(dist, -REL_CLIP, REL_CLIP) + REL_CLIP
    return jnp.take(table, idx, axis=1).astype(jnp.float32)


def band_attention_prompt(q, k, v, rel_table):
    b, s, h, dh = q.shape
    nc = s // CHUNK
    pad = ((0, 0), (WINDOW, 0), (0, 0), (0, 0))
    kp = jnp.pad(k, pad)
    vp = jnp.pad(v, pad)
    idx = jnp.arange(nc)[:, None] * CHUNK + jnp.arange(BAND)[None, :]
    kb = kp[:, idx]
    vb = vp[:, idx]
    qb = q.reshape(b, nc, CHUNK, h, dh)
    dist = jnp.arange(CHUNK)[:, None] + WINDOW - jnp.arange(BAND)[None, :]
    valid = jnp.where(idx >= WINDOW, 0.0, NEG).astype(jnp.float32)
    bias = rel_bias(rel_table, dist)[None] + valid[:, None, None, :]
    out = softmax_attend(qb, kb, vb, bias[None])
    return out.reshape(b, s, h, dh)


def band_attention_sample(q, k, v, k_past, v_past, rel_table):
    p_len = k_past.shape[1]
    t = q.shape[1]
    kk = jnp.concatenate([k_past, k], axis=1)
    vv = jnp.concatenate([v_past, v], axis=1)
    dist = (p_len + jnp.arange(t))[:, None] - jnp.arange(p_len + t)[None, :]
    return softmax_attend(q, kk, vv, rel_bias(rel_table, dist)[None])


def memory_kv(mem, g_mem, w_mem_kv, g_k_m):
    b, n, _ = mem.shape
    k, v = jnp.split(rmsnorm(mem, g_mem) @ w_mem_kv, 2, axis=-1)
    k = rmsnorm(k.reshape(b, n, N_HEADS_M, HEAD_DIM), g_k_m)
    return k, v.reshape(b, n, N_HEADS_M, HEAD_DIM)


def _lin_combine(left, right):
    a1, b1 = left
    a2, b2 = right
    return a1 * a2, a2 * b1 + b2


def rg_lru(x, h0, w_a, b_a, w_i, b_i, lam):
    b, t, _ = x.shape
    xb = x.reshape(b, t, N_RNN_BLOCKS, RNN_BLOCK)

    def gate(w, bias):
        z = jnp.einsum('btni,nij->btnj', xb, w).reshape(b, t, D_RNN) + bias
        return jax.nn.sigmoid(z.astype(jnp.float32))

    r = gate(w_a, b_a)
    i = gate(w_i, b_i)
    log_a = -LRU_C * r * jax.nn.softplus(-lam.astype(jnp.float32))
    a = jnp.exp(log_a)
    u = jnp.sqrt(-jnp.expm1(2.0 * log_a)) * (i * x.astype(jnp.float32))
    a_cum, b_cum = lax.associative_scan(_lin_combine, (a, u), axis=1)
    h = a_cum * h0.astype(jnp.float32)[:, None] + b_cum
    return h.astype(x.dtype), h[:, -1].astype(x.dtype)


def trunk_layer(x, attn_a, mem_k, mem_v, b_conv_past, b_h0, f_conv_past,
                g_attn, w_in, g_q_a, g_k_a, g_q_m, conv_b_w, conv_b_b,
                w_rg_a, b_rg_a, w_rg_i, b_rg_i, lru_lambda, w_out,
                g_ffn, w_up, conv_f_w, conv_f_b, w_down):
    b, t, _ = x.shape
    z = rmsnorm(x, g_attn) @ w_in
    q_a, k_a, v_a, q_m, x_b, g_b = jnp.split(z, SPLITS, axis=-1)
    q_a = rmsnorm(q_a.reshape(b, t, N_HEADS_A, HEAD_DIM), g_q_a)
    k_a = rmsnorm(k_a.reshape(b, t, N_HEADS_A, HEAD_DIM), g_k_a)
    v_a = v_a.reshape(b, t, N_HEADS_A, HEAD_DIM)
    o_a = attn_a(q_a, k_a, v_a).reshape(b, t, D_A)
    q_m = rmsnorm(q_m.reshape(b, t, N_HEADS_M, HEAD_DIM), g_q_m)
    o_m = softmax_attend(q_m, mem_k, mem_v, 0.0).reshape(b, t, D_M)
    xc, b_conv_new = causal_dwconv(x_b, b_conv_past, conv_b_w, conv_b_b)
    h, b_h_new = rg_lru(xc, b_h0, w_rg_a, b_rg_a, w_rg_i, b_rg_i, lru_lambda)
    o_b = h * jax.nn.gelu(g_b)
    x = x + jnp.concatenate([o_a, o_m, o_b], axis=-1) @ w_out
    up = rmsnorm(x, g_ffn) @ w_up
    up, f_conv_new = causal_dwconv(up, f_conv_past, conv_f_w, conv_f_b)
    val, gt = jnp.split(up, 2, axis=-1)
    x = x + (jax.nn.gelu(gt) * val) @ w_down
    return x, k_a, v_a, b_conv_new, b_h_new, f_conv_new


def setup_inputs(seed: int = 0) -> dict:
    key = jax.random.key(seed)
    keys = jax.random.split(key, 40)
    counter = [0]
    f32 = jnp.float32

    def nk():
        k = keys[counter[0]]
        counter[0] += 1
        return k

    def nrm(shape, scale=1.0):
        return jax.random.normal(nk(), shape, f32) * scale

    def gain(shape):
        return 1.0 + 0.1 * nrm(shape)

    L = DEPTH
    a_rows = min(WINDOW, PAST_LEN)
    inputs = {
        'x_prompt': nrm((BATCH, SEQ, D_MODEL)),
        'x_sample': nrm((DEC_BATCH, DEC_SEQ, D_MODEL)),
        'cache_a_k': nrm((L, DEC_BATCH, a_rows, N_HEADS_A, HEAD_DIM)),
        'cache_a_v': nrm((L, DEC_BATCH, a_rows, N_HEADS_A, HEAD_DIM)),
        'cache_mem_k': nrm((L, DEC_BATCH, N_MEM, N_HEADS_M, HEAD_DIM)),
        'cache_mem_v': nrm((L, DEC_BATCH, N_MEM, N_HEADS_M, HEAD_DIM)),
        'cache_b_conv': nrm((L, DEC_BATCH, CONV_B - 1, D_RNN)),
        'state_b_h': nrm((L, DEC_BATCH, D_RNN), 0.5),
        'cache_f_conv': nrm((L, DEC_BATCH, CONV_F - 1, 2 * D_FF)),
        'mem_prompt': nrm((BATCH, N_MEM, D_MODEL)),
        'g_attn': gain((L, D_MODEL)),
        'w_in': nrm((L, D_MODEL, D_IN), D_MODEL ** -0.5),
        'g_q_a': gain((L, HEAD_DIM)),
        'g_k_a': gain((L, HEAD_DIM)),
        'rel_table': nrm((L, N_HEADS_A, 2 * REL_CLIP + 1), 0.3),
        'g_q_m': gain((L, HEAD_DIM)),
        'g_k_m': gain((L, HEAD_DIM)),
        'g_mem': gain((L, D_MODEL)),
        'w_mem_kv': nrm((L, D_MODEL, 2 * D_M), D_MODEL ** -0.5),
        'conv_b_w': nrm((L, CONV_B, D_RNN), CONV_B ** -0.5),
        'conv_b_b': nrm((L, D_RNN), 0.02),
        'w_rg_a': nrm((L, N_RNN_BLOCKS, RNN_BLOCK, RNN_BLOCK), RNN_BLOCK ** -0.5),
        'b_rg_a': nrm((L, D_RNN), 0.02),
        'w_rg_i': nrm((L, N_RNN_BLOCKS, RNN_BLOCK, RNN_BLOCK), RNN_BLOCK ** -0.5),
        'b_rg_i': nrm((L, D_RNN), 0.02),
    }
    a0 = jax.random.uniform(nk(), (L, D_RNN), f32, 0.9, 0.999)
    s = a0 ** (1.0 / LRU_C)
    inputs['lru_lambda'] = jnp.log(s) - jnp.log1p(-s)
    inputs['w_out'] = nrm((L, D_MIX, D_MODEL), D_MIX ** -0.5)
    inputs['g_ffn'] = gain((L, D_MODEL))
    inputs['w_up'] = nrm((L, D_MODEL, 2 * D_FF), D_MODEL ** -0.5)
    inputs['conv_f_w'] = nrm((L, CONV_F, 2 * D_FF), CONV_F ** -0.5)
    inputs['conv_f_b'] = nrm((L, 2 * D_FF), 0.02)
    inputs['w_down'] = nrm((L, D_FF, D_MODEL), D_FF ** -0.5)
    return inputs


def reference(x_prompt, x_sample, cache_a_k, cache_a_v, cache_mem_k, cache_mem_v,
              cache_b_conv, state_b_h, cache_f_conv, mem_prompt,
              g_attn, w_in, g_q_a, g_k_a, rel_table, g_q_m, g_k_m, g_mem, w_mem_kv,
              conv_b_w, conv_b_b, w_rg_a, b_rg_a, w_rg_i, b_rg_i, lru_lambda,
              w_out, g_ffn, w_up, conv_f_w, conv_f_b, w_down):
    xp, xs = x_prompt, x_sample
    bp, sp, _ = xp.shape
    keep = min(WINDOW, sp)
    ak_p, av_p, mk_p, mv_p, bc_p, bh_p, fc_p = [], [], [], [], [], [], []
    ak_s, av_s, bc_s, bh_s, fc_s = [], [], [], [], []
    for l in range(DEPTH):
        shared = (g_attn[l], w_in[l], g_q_a[l], g_k_a[l], g_q_m[l], conv_b_w[l], conv_b_b[l],
                  w_rg_a[l], b_rg_a[l], w_rg_i[l], b_rg_i[l], lru_lambda[l], w_out[l],
                  g_ffn[l], w_up[l], conv_f_w[l], conv_f_b[l], w_down[l])
        mem_k, mem_v = memory_kv(mem_prompt, g_mem[l], w_mem_kv[l], g_k_m[l])
        xp, k_a, v_a, bc, bh, fc = trunk_layer(
            xp, functools.partial(band_attention_prompt, rel_table=rel_table[l]),
            mem_k, mem_v,
            jnp.zeros((bp, CONV_B - 1, D_RNN), xp.dtype),
            jnp.zeros((bp, D_RNN), xp.dtype),
            jnp.zeros((bp, CONV_F - 1, 2 * D_FF), xp.dtype),
            *shared)
        ak_p.append(k_a[:, sp - keep:])
        av_p.append(v_a[:, sp - keep:])
        mk_p.append(mem_k)
        mv_p.append(mem_v)
        bc_p.append(bc)
        bh_p.append(bh)
        fc_p.append(fc)
        xs, k_a, v_a, bc, bh, fc = trunk_layer(
            xs, functools.partial(band_attention_sample, k_past=cache_a_k[l],
                                  v_past=cache_a_v[l], rel_table=rel_table[l]),
            cache_mem_k[l], cache_mem_v[l], cache_b_conv[l], state_b_h[l], cache_f_conv[l],
            *shared)
        ak_s.append(k_a)
        av_s.append(v_a)
        bc_s.append(bc)
        bh_s.append(bh)
        fc_s.append(fc)
    return (xp, xs,
            jnp.stack(ak_p), jnp.stack(av_p), jnp.stack(mk_p), jnp.stack(mv_p),
            jnp.stack(bc_p), jnp.stack(bh_p), jnp.stack(fc_p),
            jnp.stack(ak_s), jnp.stack(av_s), jnp.stack(bc_s), jnp.stack(bh_s), jnp.stack(fc_s))
```

```cpp
#include <hip/hip_runtime.h>
#include <hip/hip_cooperative_groups.h>
#include <cstdio>
#include <cstdint>
namespace cg = cooperative_groups;

#define LAS __attribute__((address_space(3)))
typedef unsigned short bf16_t;
typedef short bf16x8 __attribute__((ext_vector_type(8)));
typedef short s16x4 __attribute__((ext_vector_type(4)));
typedef float f32x4 __attribute__((ext_vector_type(4)));
typedef float f32x16 __attribute__((ext_vector_type(16)));
typedef unsigned u32x4 __attribute__((ext_vector_type(4)));
typedef unsigned u32x2 __attribute__((ext_vector_type(2)));

constexpr int DM = 2048, MP = 16384, MS = 512, MT = MP + MS, MMEM = 1024, MA1 = MT + MMEM;
constexpr int DIN = 4608, NINT = DIN + 1024, DFF = 6144, DUP = 12288;
constexpr float EPS = 1e-6f;
constexpr float LOG2E = 1.4426950408889634f;
constexpr float QSCALE = 0.08838834764831845f * LOG2E;
constexpr size_t O_Y = 0, O_AKP = 34603008, O_AVP = 36700160, O_MKP = 38797312, O_MVP = 39321600, O_BCP = 39845888, O_BHP = 39852032,
                 O_FCP = 39854080, O_AKS = 39952384, O_AVS = 40476672, O_BCS = 41000960, O_BHS = 41025536, O_FCS = 41033728;
constexpr size_t MiB = 1u << 20;
constexpr size_t WS_CTL = 0, CTL_BYTES = 1 * MiB;
constexpr size_t WS_WIN = 2 * MiB, WS_WOUT = 24 * MiB, WS_WUP = 32 * MiB, WS_WDN = 80 * MiB;
constexpr size_t WS_A1 = 104 * MiB;
constexpr size_t WS_Z = 174 * MiB;
constexpr size_t WS_ZM = 323 * MiB;
constexpr size_t WS_MIX = 325 * MiB;
constexpr size_t WS_KS = 391 * MiB, WS_VS = 408 * MiB;
constexpr size_t WS_MKP = 425 * MiB, WS_MVP = 426 * MiB, WS_MKS = 427 * MiB, WS_MVS = 431 * MiB;
constexpr size_t WS_UB = 435 * MiB;
constexpr size_t WS_END = 460 * MiB;
constexpr size_t WS_HS = 500 * MiB;
constexpr int CW_QUEUE = 0, CW_CNT3 = 1024, CW_CNT5 = 2048, CW_CNT4 = 3072, CW_BAR = 4096, CW_SDONE = 128, CW_UDONE = 192, CW_QCONV = 256;
constexpr int CW_SSQ = 16384;

__device__ __forceinline__ unsigned cvt_pk(float lo, float hi) { unsigned r; asm volatile("v_cvt_pk_bf16_f32 %0, %1, %2" : "=v"(r) : "v"(lo), "v"(hi)); return r; }
__device__ __forceinline__ float bf_lo(unsigned w) { return __uint_as_float(w << 16); }
__device__ __forceinline__ float bf_hi(unsigned w) { return __uint_as_float(w & 0xffff0000u); }
__device__ __forceinline__ float bf1(bf16_t h) { return __uint_as_float(((unsigned)h) << 16); }
__device__ __forceinline__ float sigmoidf_(float x) { return __builtin_amdgcn_rcpf(1.f + __builtin_amdgcn_exp2f(-LOG2E * x)); }
__device__ __forceinline__ float gelu_tanh(float x) { const float t = (1.5957691216057308f * LOG2E) * (x + 0.044715f * x * x * x); return x * __builtin_amdgcn_rcpf(1.f + __builtin_amdgcn_exp2f(-t)); }
__device__ __forceinline__ int crow(int r, int hi) { return (r & 3) + 8 * (r >> 2) + 4 * hi; }
__device__ __forceinline__ unsigned off_b(unsigned row, unsigned ch) { return 256u * row + 16u * (ch ^ (((row & 3) << 2) | ((row >> 2) & 3))); }
__device__ __forceinline__ float wave_sum(float v) {
#pragma unroll
    for (int o = 1; o < 64; o <<= 1) v += __shfl_xor(v, o);
    return v;
}

namespace pg8 {
constexpr int BM = 256, BK = 64, HALF = 128, HTB = HALF * BK * 2, STAGE_BYTES = 8 * HTB, NXCD = 8, WGM = 8;
__host__ __device__ __forceinline__ int lds_byte(int r, int c) { const int st = (r >> 4) * 2 + (c >> 5), rr = r & 15, cc = c & 31, ob = rr * 64 + cc * 2; return st * 1024 + (ob ^ (((ob >> 9) & 1) << 5)); }
__host__ __device__ __forceinline__ void stage_rc(int b, int& R, int& C) { const int st = b / 1024, sb = b % 1024, swz = sb ^ (((sb >> 9) & 1) << 5); R = (st >> 1) * 16 + swz / 64; C = (st & 1) * 32 + (swz % 64) / 2; }
__host__ __device__ __forceinline__ int perm32(int rho) { const int n = rho >> 4, i = rho & 15; return 8 * (i >> 2) + 4 * n + (i & 3); }

struct Unit { int pm, pn, koff, nt, ks, nsplit, tile; };
struct Gemm { const bf16_t* A; const bf16_t* Bt; const bf16_t* A2; int pm2; };

template <int NM, int NN, int NT, int NEXTRA, int EX_PM0, int EX_PN0, int EX_W, int SP_TILES, int SP_PM0, int SP_SPLIT>
struct SchedT {
    static constexpr int nwg = NM * NN, sp_count = SP_TILES * SP_SPLIT, sp_nt = NT / SP_SPLIT;
    int G, c; float* part; unsigned* cnt;
    __device__ __forceinline__ bool next(int i, Unit& u) const {
        int L = i * G + c; if (L >= sp_count + nwg + NEXTRA) return false;
        u.koff = 0; u.nt = NT; u.ks = 0; u.nsplit = 1; u.tile = 0;
        if (SP_TILES > 0 && L < sp_count) { const int tile = L / SP_SPLIT, ks = L % SP_SPLIT; u.pm = SP_PM0 + tile / NN; u.pn = tile % NN; u.koff = ks * sp_nt * BK; u.nt = sp_nt; u.ks = ks; u.nsplit = SP_SPLIT; u.tile = tile; return true; }
        L -= sp_count;
        if (NEXTRA > 0 && L >= nwg) { const int e = L - nwg; u.pm = EX_PM0 + e / EX_W; u.pn = EX_PN0 + e % EX_W; return true; }
        int wgid = L; { constexpr int q = nwg / NXCD, r = nwg % NXCD; const int xcd = wgid % NXCD, off = wgid / NXCD; wgid = (xcd < r ? xcd * (q + 1) : r * (q + 1) + (xcd - r) * q) + off; }
        constexpr int nig = WGM * NN; const int gid = wgid / nig, fm = gid * WGM, gsz = (NM - fm) < WGM ? (NM - fm) : WGM;
        u.pm = fm + ((wgid % nig) % gsz); u.pn = (wgid % nig) / gsz; return true;
    }
};

struct SchedOne {
    int pm, pn, nt; float* part; unsigned* cnt;
    __device__ __forceinline__ bool next(int i, Unit& u) const { if (i > 0) return false; u.pm = pm; u.pn = pn; u.koff = 0; u.nt = nt; u.ks = 0; u.nsplit = 1; u.tile = 0; return true; }
};

template <class Epi, bool PERMA, class Sched, int KP>
__device__ __forceinline__ void gemm_phase(LAS unsigned char* lds, const Gemm g, const Sched& S, const Epi& E) {
    int tid_ = threadIdx.x; asm volatile("" : "+v"(tid_));
    const int tid = tid_, wid = __builtin_amdgcn_readfirstlane(tid >> 6), lane = tid & 63, wr = wid >> 2, wc = wid & 3, fr = lane & 15, fq = lane >> 4;
    constexpr int K = KP;
    unsigned voffA[2], voffB[2];
#pragma unroll
    for (int i = 0; i < 2; ++i) { int R, C; stage_rc(tid * 16 + i * 8192, R, C); const int Rb = Epi::PERM ? ((R & ~31) + perm32(R & 31)) : R;
        const int Ra = PERMA ? (8 * (16 * (R >> 6) + (R & 15)) + ((R >> 4) & 3)) : R;
        voffA[i] = (unsigned)(Ra * K + C) * 2u; voffB[i] = (unsigned)(Rb * K + C) * 2u; }
    const size_t kstep = (size_t)(BK * 2);
    const size_t hstepB = (size_t)HALF * K * 2;
    const size_t hstepA = PERMA ? (size_t)4 * K * 2 : hstepB;
    const size_t tstep = 2 * hstepB;
    const unsigned ldsw = (unsigned)wid * 1024u;
    const int aoff = lds_byte(wr * 64 + fr, fq * 8), boff = lds_byte(wc * 32 + fr, fq * 8);
#define PG8_SA(b, h) (((b) * 2 + (h)) * HTB)
#define PG8_SB(b, h) ((4 + (b) * 2 + (h)) * HTB)
#define PG8_STAGE(bufoff, gbase, voff) do { _Pragma("unroll") for (int _i = 0; _i < 2; ++_i) \
        __builtin_amdgcn_global_load_lds((const unsigned*)((const char*)(gbase) + (voff)[_i]), (LAS unsigned*)(lds + (bufoff) + ldsw + _i * 8192), 16, 0, 0); } while (0)
#define PG8_LDA(dst, b, h) do { _Pragma("unroll") for (int m = 0; m < 4; ++m) _Pragma("unroll") for (int k = 0; k < 2; ++k) dst[m][k] = *(const LAS bf16x8*)(lds + PG8_SA(b, h) + aoff + m * 2048 + k * 1024); } while (0)
#define PG8_LDB(dst, b, h) do { _Pragma("unroll") for (int n = 0; n < 2; ++n) _Pragma("unroll") for (int k = 0; k < 2; ++k) dst[n][k] = *(const LAS bf16x8*)(lds + PG8_SB(b, h) + boff + n * 2048 + k * 1024); } while (0)
#define PG8_MMA(ai, bj, At, Bt) do { __builtin_amdgcn_s_setprio(1); _Pragma("unroll") for (int m = 0; m < 4; ++m) _Pragma("unroll") for (int n = 0; n < 2; ++n) _Pragma("unroll") for (int k = 0; k < 2; ++k) \
        acc[ai][bj][m][n] = __builtin_amdgcn_mfma_f32_16x16x32_bf16(Bt[n][k], At[m][k], acc[ai][bj][m][n], 0, 0, 0); __builtin_amdgcn_s_setprio(0); } while (0)
#define PG8_WAIT_V(n) asm volatile("s_waitcnt vmcnt(" #n ")" ::: "memory")
#define PG8_WAIT_L(n) asm volatile("s_waitcnt lgkmcnt(" #n ")" ::: "memory")
#define PG8_BAR __builtin_amdgcn_s_barrier()
#define PG8_SCHED __builtin_amdgcn_sched_barrier(0)
    Unit cur, nxt; int ui = 0;
    if (!S.next(0, cur)) return;
    f32x4 acc[2][2][4][2];
#pragma unroll
    for (int a = 0; a < 2; ++a)
#pragma unroll
        for (int b = 0; b < 2; ++b)
#pragma unroll
            for (int m = 0; m < 4; ++m)
#pragma unroll
                for (int n = 0; n < 2; ++n) acc[a][b][m][n] = (f32x4){0.f, 0.f, 0.f, 0.f};
    bf16x8 At[4][2], B0[2][2], B1[2][2];
#define PG8_AOF(u) ((u).pm >= g.pm2 ? (const char*)g.A2 + (size_t)((u).pm - g.pm2) * tstep : (const char*)g.A + (size_t)(u).pm * tstep)
    const char* cA = PG8_AOF(cur) + (size_t)cur.koff * 2; const char* cB = (const char*)g.Bt + (size_t)cur.pn * tstep + (size_t)cur.koff * 2;
    PG8_STAGE(PG8_SB(0, 0), cB, voffB); PG8_STAGE(PG8_SB(0, 1), cB + hstepB, voffB); PG8_STAGE(PG8_SA(0, 0), cA, voffA); PG8_STAGE(PG8_SA(0, 1), cA + hstepA, voffA);
    if (wr == 1) PG8_BAR;
    PG8_WAIT_V(2); PG8_BAR;
    PG8_STAGE(PG8_SB(1, 0), cB + kstep, voffB); PG8_STAGE(PG8_SA(1, 0), cA + kstep, voffA); PG8_STAGE(PG8_SB(1, 1), cB + hstepB + kstep, voffB);
    PG8_WAIT_V(6); PG8_BAR;
    for (;;) {
        E.prefetch(lds + STAGE_BYTES, cur, ui & 1, wid, lane);
        const bool has_next = S.next(ui + 1, nxt);
        const char* nA = has_next ? PG8_AOF(nxt) + (size_t)nxt.koff * 2 : cA; const char* nB = has_next ? (const char*)g.Bt + (size_t)nxt.pn * tstep + (size_t)nxt.koff * 2 : cB;
        const int nt = cur.nt;
        for (int t = 0; t < nt; t += 2) {
            const bool last = (t == nt - 2);
            const char* a1 = cA + (size_t)(t + 1) * kstep;
            const char* a2 = last ? nA : cA + (size_t)(t + 2) * kstep; const char* b2 = last ? nB : cB + (size_t)(t + 2) * kstep;
            const char* a3 = a2 + kstep; const char* b3 = b2 + kstep;
            PG8_LDB(B0, 0, 0); PG8_LDB(B1, 0, 1); PG8_SCHED; PG8_LDA(At, 0, 0); PG8_STAGE(PG8_SA(1, 1), a1 + hstepA, voffA);
            PG8_WAIT_V(8); PG8_WAIT_L(0); PG8_BAR; PG8_MMA(0, 0, At, B0); PG8_MMA(0, 1, At, B1); PG8_BAR; PG8_SCHED;
            PG8_LDA(At, 0, 1); PG8_STAGE(PG8_SB(0, 0), b2, voffB); PG8_STAGE(PG8_SB(0, 1), b2 + hstepB, voffB); PG8_STAGE(PG8_SA(0, 0), a2, voffA);
            PG8_WAIT_V(8); PG8_WAIT_L(0); PG8_BAR; PG8_MMA(1, 0, At, B0); PG8_MMA(1, 1, At, B1); PG8_BAR; PG8_SCHED;
            PG8_LDB(B0, 1, 0); PG8_LDB(B1, 1, 1); PG8_SCHED; PG8_LDA(At, 1, 0); PG8_STAGE(PG8_SA(0, 1), a2 + hstepA, voffA);
            PG8_WAIT_V(8); PG8_WAIT_L(0); PG8_BAR; PG8_MMA(0, 0, At, B0); PG8_MMA(0, 1, At, B1); PG8_BAR; PG8_SCHED;
            PG8_LDA(At, 1, 1); PG8_STAGE(PG8_SB(1, 0), b3, voffB); PG8_STAGE(PG8_SB(1, 1), b3 + hstepB, voffB); PG8_STAGE(PG8_SA(1, 0), a3, voffA);
            PG8_WAIT_V(8); PG8_WAIT_L(0); PG8_BAR; PG8_MMA(1, 0, At, B0); PG8_MMA(1, 1, At, B1); PG8_BAR; PG8_SCHED;
        }
        if (wr == 0) PG8_BAR;
        bool run_epi = true;
        if (cur.nsplit > 1) {
            typedef unsigned long long u64;
            u64* myp = (u64*)S.part + ((size_t)(cur.tile * cur.nsplit + cur.ks) * 8 + wid) * 4096 + lane;
#pragma unroll
            for (int a = 0; a < 2; ++a)
#pragma unroll
                for (int b = 0; b < 2; ++b)
#pragma unroll
                    for (int m = 0; m < 4; ++m)
#pragma unroll
                        for (int n = 0; n < 2; ++n) { const f32x4 v = acc[a][b][m][n]; const int r = ((a * 2 + b) * 4 + m) * 2 + n;
                            __hip_atomic_store(myp + (2 * r) * 64, ((u64)__float_as_uint(v[1]) << 32) | __float_as_uint(v[0]), __ATOMIC_RELAXED, __HIP_MEMORY_SCOPE_AGENT);
                            __hip_atomic_store(myp + (2 * r + 1) * 64, ((u64)__float_as_uint(v[3]) << 32) | __float_as_uint(v[2]), __ATOMIC_RELAXED, __HIP_MEMORY_SCOPE_AGENT); }
            asm volatile("s_waitcnt vmcnt(0)" ::: "memory");
            unsigned old = 0;
            if (lane == 0) old = __hip_atomic_fetch_add(S.cnt + cur.tile * 8 + wid, 1u, __ATOMIC_RELAXED, __HIP_MEMORY_SCOPE_AGENT);
            old = __builtin_amdgcn_readfirstlane(old);
            if (old == (unsigned)(cur.nsplit - 1)) {
#pragma unroll
                for (int a = 0; a < 2; ++a)
#pragma unroll
                    for (int b = 0; b < 2; ++b)
#pragma unroll
                        for (int m = 0; m < 4; ++m)
#pragma unroll
                            for (int n = 0; n < 2; ++n) acc[a][b][m][n] = (f32x4){0.f, 0.f, 0.f, 0.f};
                for (int k2 = 0; k2 < cur.nsplit; ++k2) {
                    u64* pp = (u64*)S.part + ((size_t)(cur.tile * cur.nsplit + k2) * 8 + wid) * 4096 + lane;
#pragma unroll
                    for (int a = 0; a < 2; ++a)
#pragma unroll
                        for (int b = 0; b < 2; ++b)
#pragma unroll
                            for (int m = 0; m < 4; ++m)
#pragma unroll
                                for (int n = 0; n < 2; ++n) { const int r = ((a * 2 + b) * 4 + m) * 2 + n;
                                    typedef float f32x2 __attribute__((ext_vector_type(2)));
                                    const f32x2 lo = *(const f32x2*)(pp + (2 * r) * 64), hi2 = *(const f32x2*)(pp + (2 * r + 1) * 64);
                                    acc[a][b][m][n] += (f32x4){lo[0], lo[1], hi2[0], hi2[1]}; }
                }
            } else run_epi = false;
        }
        if (run_epi) E(acc, cur, wr, wc, fr, fq, lds + STAGE_BYTES, ui & 1);
        if (!has_next) break;
#pragma unroll
        for (int a = 0; a < 2; ++a)
#pragma unroll
            for (int b = 0; b < 2; ++b)
#pragma unroll
                for (int m = 0; m < 4; ++m)
#pragma unroll
                    for (int n = 0; n < 2; ++n) acc[a][b][m][n] = (f32x4){0.f, 0.f, 0.f, 0.f};
        cur = nxt; cA = nA; cB = nB; ++ui;
        if (wr == 1) PG8_BAR;
    }
    PG8_WAIT_V(0);
    PG8_BAR;
#undef PG8_AOF
#undef PG8_SA
#undef PG8_SB
#undef PG8_STAGE
#undef PG8_LDA
#undef PG8_LDB
#undef PG8_MMA
#undef PG8_WAIT_V
#undef PG8_WAIT_L
#undef PG8_BAR
#undef PG8_SCHED
}

struct EpiZ {
    __device__ __forceinline__ void prefetch(LAS unsigned char*, const Unit&, int, int, int) const {}
    static constexpr bool PERM = true;
    unsigned char* ws; float* out; const float* const* gains;
    __device__ __forceinline__ void operator()(const f32x4 (&acc)[2][2][4][2], const Unit& u, int wr, int wc, int fr, int fq, LAS unsigned char* xl, int par) const {
        const bool mem = u.pm >= 66;
        const int pn = mem ? u.pn - 18 : u.pn;
        int kind; const float* gp;
        int gi;
        if (mem) { kind = pn < 2 ? 1 : 2; gi = 4; }
        else if (pn < 4) { kind = 0; gi = 0; } else if (pn < 8) { kind = 1; gi = 1; } else if (pn == 12 || pn == 13) { kind = 0; gi = 3; } else { kind = 2; gi = 0; }
        gp = gains[gi];
        const int dcol = wc * 32 + 8 * fq;
        float rs[2][4][2];
#pragma unroll
        for (int ai = 0; ai < 2; ++ai)
#pragma unroll
            for (int m = 0; m < 4; ++m) { rs[ai][m][0] = 1.f; rs[ai][m][1] = 1.f; }
        if (kind != 2) {
            LAS float* P = (LAS float*)xl;
#pragma unroll
            for (int ai = 0; ai < 2; ++ai)
#pragma unroll
                for (int m = 0; m < 4; ++m)
#pragma unroll
                    for (int bj = 0; bj < 2; ++bj) { const f32x4 v0 = acc[ai][bj][m][0], v1 = acc[ai][bj][m][1];
                        float ss = (v0[0] * v0[0] + v0[1] * v0[1]) + (v0[2] * v0[2] + v0[3] * v0[3]) + (v1[0] * v1[0] + v1[1] * v1[1]) + (v1[2] * v1[2] + v1[3] * v1[3]);
                        ss += __shfl_xor(ss, 16); ss += __shfl_xor(ss, 32);
                        if (fq == 0) P[((ai * HALF + wr * 64 + m * 16 + fr) * 2 + bj) * 4 + wc] = ss; }
            asm volatile("s_waitcnt lgkmcnt(0)" ::: "memory"); __builtin_amdgcn_s_barrier(); asm volatile("" ::: "memory");
#pragma unroll
            for (int ai = 0; ai < 2; ++ai)
#pragma unroll
                for (int m = 0; m < 4; ++m)
#pragma unroll
                    for (int bj = 0; bj < 2; ++bj) { const f32x4 q = *(const LAS f32x4*)(P + ((ai * HALF + wr * 64 + m * 16 + fr) * 2 + bj) * 4);
                        rs[ai][m][bj] = rsqrtf(((q[0] + q[1]) + (q[2] + q[3])) * (1.f / 128.f) + EPS); }
        }
        float g8[8];
        { const f32x4 ga = *(const f32x4*)(gp + dcol), gb = *(const f32x4*)(gp + dcol + 4); const float sc = kind == 0 ? QSCALE : 1.f;
#pragma unroll
          for (int e = 0; e < 4; ++e) { g8[e] = kind == 2 ? 1.f : ga[e] * sc; g8[4 + e] = kind == 2 ? 1.f : gb[e] * sc; } }
#pragma unroll
        for (int ai = 0; ai < 2; ++ai)
#pragma unroll
            for (int m = 0; m < 4; ++m) {
                const int rl = ai * HALF + wr * 64 + m * 16 + fr;
#pragma unroll
                for (int bj = 0; bj < 2; ++bj) {
                    const float r = rs[ai][m][bj]; float x[8];
#pragma unroll
                    for (int e = 0; e < 4; ++e) { x[e] = acc[ai][bj][m][0][e] * r * g8[e]; x[4 + e] = acc[ai][bj][m][1][e] * r * g8[4 + e]; }
                    u32x4 w; w.x = cvt_pk(x[0], x[1]); w.y = cvt_pk(x[2], x[3]); w.z = cvt_pk(x[4], x[5]); w.w = cvt_pk(x[6], x[7]);
                    if (mem) {
                        const int mr = (u.pm - 66) * BM + rl, hh = pn * 2 + bj, hd = hh & 3;
                        *(u32x4*)((bf16_t*)(ws + (hh < 4 ? WS_MKP : WS_MVP)) + (size_t)mr * 512 + hd * 128 + dcol) = w;
                        float* op = out + (hh < 4 ? O_MKP : O_MVP) + (size_t)mr * 512 + hd * 128 + dcol;
                        *(f32x4*)op = (f32x4){x[0], x[1], x[2], x[3]}; *(f32x4*)(op + 4) = (f32x4){x[4], x[5], x[6], x[7]};
                    } else {
                        const int row = u.pm * BM + rl, hh = pn * 2 + bj, col = hh * 128 + dcol;
                        *(u32x4*)((bf16_t*)(ws + WS_Z) + (size_t)row * DIN + col) = w;
                        const bool smp = row >= MP; const int t = smp ? ((row - MP) & 31) : (row & 4095); const int sq = smp ? ((row - MP) >> 5) : (row >> 12);
                        if (hh >= 8 && hh < 24) {
                            const bool isk = hh < 16; const int hd = hh & 7;
                            if (smp) *(u32x4*)((bf16_t*)(ws + (isk ? WS_KS : WS_VS)) + ((size_t)sq * 544 + 512 + t) * 1024 + hd * 128 + dcol) = w;
                            if (smp || t >= 3584) {
                                float* op = smp ? out + (isk ? O_AKS : O_AVS) + (size_t)(row - MP) * 1024 : out + (isk ? O_AKP : O_AVP) + (size_t)(sq * 512 + t - 3584) * 1024;
                                op += hd * 128 + dcol;
                                *(f32x4*)op = (f32x4){x[0], x[1], x[2], x[3]}; *(f32x4*)(op + 4) = (f32x4){x[4], x[5], x[6], x[7]};
                            }
                        } else if (hh >= 28 && hh < 32) {
                            const int tl3 = smp ? t - 29 : t - 4093;
                            if (tl3 >= 0) { float* op = out + (smp ? O_BCS : O_BCP) + (size_t)(sq * 3 + tl3) * 512 + (col - 3584);
                                *(f32x4*)op = (f32x4){x[0], x[1], x[2], x[3]}; *(f32x4*)(op + 4) = (f32x4){x[4], x[5], x[6], x[7]}; }
                        }
                    }
                }
            }
    }
};
struct EpiOut {
    __device__ __forceinline__ void prefetch(LAS unsigned char*, const Unit&, int, int, int) const {}
    static constexpr bool PERM = false;
    const float* xp; const float* xs; float* out; bf16_t* XG; const float* gffn; float* ssq;
    __device__ __forceinline__ void operator()(const f32x4 (&acc)[2][2][4][2], const Unit& u, int wr, int wc, int fr, int fq, LAS unsigned char* xl, int par) const {
        const int row0 = u.pm * BM + wr * 64 + fr, col0 = u.pn * BM + wc * 32 + 4 * fq;
#pragma unroll
        for (int ai = 0; ai < 2; ++ai)
#pragma unroll
            for (int m = 0; m < 4; ++m) { const int row = row0 + ai * HALF + m * 16;
                const float* xrow = row < MP ? xp + (size_t)row * DM : xs + (size_t)(row - MP) * DM; float s = 0.f;
#pragma unroll
                for (int bj = 0; bj < 2; ++bj)
#pragma unroll
                    for (int n = 0; n < 2; ++n) { const int col = col0 + bj * HALF + n * 16;
                        const f32x4 x1 = *(const f32x4*)(xrow + col) + acc[ai][bj][m][n];
                        *(f32x4*)(out + (size_t)row * DM + col) = x1;
                        s += (x1[0] * x1[0] + x1[1] * x1[1]) + (x1[2] * x1[2] + x1[3] * x1[3]);
                        const f32x4 gv = *(const f32x4*)(gffn + col);
                        u32x2 w; w.x = cvt_pk(x1[0] * gv[0], x1[1] * gv[1]); w.y = cvt_pk(x1[2] * gv[2], x1[3] * gv[3]);
                        *(u32x2*)(XG + (size_t)row * DM + col) = w; }
                s += __shfl_xor(s, 16); s += __shfl_xor(s, 32);
                if (fq == 0) atomicAdd(ssq + row, s); }
    }
};
struct EpiDown {
    __device__ __forceinline__ void prefetch(LAS unsigned char*, const Unit&, int, int, int) const {}
    static constexpr bool PERM = false;
    float* out;
    __device__ __forceinline__ void operator()(const f32x4 (&acc)[2][2][4][2], const Unit& u, int wr, int wc, int fr, int fq, LAS unsigned char* xl, int par) const {
        const int row0 = u.pm * BM + wr * 64 + fr, col0 = u.pn * BM + wc * 32 + 4 * fq;
#pragma unroll
        for (int ai = 0; ai < 2; ++ai)
#pragma unroll
            for (int m = 0; m < 4; ++m) { float* orow = out + (size_t)(row0 + ai * HALF + m * 16) * DM + col0;
#pragma unroll
                for (int bj = 0; bj < 2; ++bj)
#pragma unroll
                    for (int n = 0; n < 2; ++n) { f32x4* p = (f32x4*)(orow + bj * HALF + n * 16); *p = *p + acc[ai][bj][m][n]; } }
    }
};
struct EpiUp {
    __device__ __forceinline__ void prefetch(LAS unsigned char* xl, const Unit& u, int par, int wid, int lane) const {
        if (wid < 5) {
            const float* src;
            if (wid < 4) src = (wid < 3 ? cfw + wid * DUP : cfb) + (lane < 32 ? 0 : DFF - 128) + u.pn * 128 + 4 * lane;
            else src = ssq + u.pm * BM + 4 * lane;
            __builtin_amdgcn_global_load_lds((const unsigned*)src, (LAS unsigned*)(xl + par * 5120 + wid * 1024), 16, 0, 0);
        }
    }
    static constexpr bool PERM = true;
    const float* ssq; const float* cfw; const float* cfb; const float* cache_f; float* out; bf16_t* H; float* UB; bf16_t* HS;
    __device__ __forceinline__ void operator()(const f32x4 (&acc)[2][2][4][2], const Unit& u, int wr, int wc, int fr, int fq, LAS unsigned char* xl, int par) const {
        const int rho = 16 * wr + fr, tok0 = u.pm * BM + 8 * rho;
        const bool sample = u.pm >= 64;
        const LAS float* xp = (const LAS float*)(xl + par * 5120);
        float rs[8];
        { const f32x4 q0 = *(const LAS f32x4*)(xp + 1024 + 8 * rho), q1 = *(const LAS f32x4*)(xp + 1024 + 8 * rho + 4);
#pragma unroll
          for (int j = 0; j < 4; ++j) { rs[j] = rsqrtf(q0[j] * (1.0f / DM) + EPS); rs[4 + j] = rsqrtf(q1[j] * (1.0f / DM) + EPS); } }
        const int bnd = 2 * u.pm + wr;
        const bool from_cache = sample && ((rho & 3) == 0);
        const bool seq_start = !sample && fr == 0 && ((bnd & 31) == 0);
        const bool incomplete = !sample && fr == 0 && ((bnd & 31) != 0);
        const bool tail_writer = !sample && fr == 15 && (((bnd + 1) & 31) != 0);
        const bool fc_writer = sample ? ((rho & 3) == 3) : (rho == 31 && (u.pm & 15) == 15);
        const int sidx = sample ? (tok0 - MP) >> 5 : (tok0 >> 12);
        float* fc_out = out + (sample ? O_FCS : O_FCP) + (size_t)sidx * 2 * DUP;
#pragma unroll
        for (int n = 0; n < 2; ++n) {
            const int kap = u.pn * 128 + wc * 32 + 8 * fq + 4 * n;
            f32x4 y[2][8];
#pragma unroll
            for (int bj = 0; bj < 2; ++bj) {
                const int col = bj * DFF + kap;
                const int kl = bj * 128 + wc * 32 + 8 * fq + 4 * n;
                const f32x4 w0 = *(const LAS f32x4*)(xp + kl), w1 = *(const LAS f32x4*)(xp + 256 + kl), w2 = *(const LAS f32x4*)(xp + 512 + kl), cb = *(const LAS f32x4*)(xp + 768 + kl);
                f32x4 U[8];
#pragma unroll
                for (int j = 0; j < 8; ++j) U[j] = acc[j >> 2][bj][j & 3][n] * rs[j];
                f32x4 p1, p2;
#pragma unroll
                for (int e = 0; e < 4; ++e) { p1[e] = __shfl_up(U[7][e], 1, 16); p2[e] = __shfl_up(U[6][e], 1, 16); }
                if (from_cache) { p2 = *(const f32x4*)(cache_f + (size_t)(sidx * 2 + 0) * DUP + col); p1 = *(const f32x4*)(cache_f + (size_t)(sidx * 2 + 1) * DUP + col); }
                if (seq_start || incomplete) { p1 = (f32x4){0.f, 0.f, 0.f, 0.f}; p2 = p1; }
                if (incomplete) { *(f32x4*)(UB + ((size_t)(bnd * 4 + 2) * 2 + bj) * DFF + kap) = U[0]; *(f32x4*)(UB + ((size_t)(bnd * 4 + 3) * 2 + bj) * DFF + kap) = U[1]; }
                if (tail_writer) { *(f32x4*)(UB + ((size_t)((bnd + 1) * 4 + 0) * 2 + bj) * DFF + kap) = U[6]; *(f32x4*)(UB + ((size_t)((bnd + 1) * 4 + 1) * 2 + bj) * DFF + kap) = U[7]; }
                if (fc_writer) { *(f32x4*)(fc_out + col) = U[6]; *(f32x4*)(fc_out + DUP + col) = U[7]; }
                y[bj][0] = cb + w0 * p2 + w1 * p1 + w2 * U[0];
                y[bj][1] = cb + w0 * p1 + w1 * U[0] + w2 * U[1];
#pragma unroll
                for (int j = 2; j < 8; ++j) y[bj][j] = cb + w0 * U[j - 2] + w1 * U[j - 1] + w2 * U[j];
            }
#pragma unroll
            for (int j = 0; j < 8; ++j) {
                if (j < 2 && incomplete) continue;
                const f32x4 v = y[0][j], gt = y[1][j];
                u32x2 w; w.x = cvt_pk(gelu_tanh(gt[0]) * v[0], gelu_tanh(gt[1]) * v[1]); w.y = cvt_pk(gelu_tanh(gt[2]) * v[2], gelu_tanh(gt[3]) * v[3]);
                *(u32x2*)((sample ? HS + (size_t)(tok0 - MP + j) * DFF : H + (size_t)(tok0 + j) * DFF) + kap) = w;
            }
        }
    }
};
}

struct Args { const float* in[32]; float* out; unsigned char* ws; };
constexpr int LDS_BYTES = 147456;
constexpr int ATT_REGION = 16896, ATT_TAB = 8 * ATT_REGION, ATT_LSM = ATT_TAB + 3328;
constexpr int LRU_XCT = 0, LRU_AGG = 65536, LRU_CW = 81920, LRU_W = 83968;
constexpr int MISC_OFF = 147328;


#define XB_TMO      128
#define XB_XCNT(j)  (256  + 64 * (j))
#define XB_XSUB(j)  (1280 + 64 * (j))
#define XB_XGEN(j)  (2304 + 64 * (j))
#define XB_TOP      3328
#define XB_TOPGEN   3392
#define XCD_BAR_WORDS 3456
#define XB_SPIN_CAP (1u << 18)
__device__ __forceinline__ unsigned xb_ld(unsigned* p)              { return __hip_atomic_load(p, __ATOMIC_RELAXED, __HIP_MEMORY_SCOPE_AGENT); }
__device__ __forceinline__ unsigned xb_add(unsigned* p, unsigned v) { return __hip_atomic_fetch_add(p, v, __ATOMIC_RELAXED, __HIP_MEMORY_SCOPE_AGENT); }
__device__ __forceinline__ unsigned xb_xcc_id() { return (unsigned)__builtin_amdgcn_s_getreg((3 << 11) | 20) & 0xFu; }
#define XB_SPIN(cond, bar) do { unsigned _sp = 0; while (cond) { __builtin_amdgcn_s_sleep(1); \
    if ((++_sp & 255u) == 0u) { if (xb_ld(&(bar)[XB_TMO])) break; if (_sp > XB_SPIN_CAP) { atomicAdd(&(bar)[XB_TMO], 1u); break; } } } } while (0)
struct XcdBarrier { unsigned* bar; unsigned x; volatile LAS unsigned* st; };
__device__ __forceinline__ XcdBarrier xcd_barrier_post(unsigned* bar, volatile LAS unsigned* st) {
    XcdBarrier b; b.bar = bar; b.x = xb_xcc_id(); b.st = st;
    if (threadIdx.x == 0) (void)xb_add(&bar[XB_XCNT(b.x)], 1u);
    return b;
}
__device__ __forceinline__ void xcd_barrier_complete(unsigned* bar, unsigned x, unsigned& nloc, unsigned& nx) {
    const unsigned G = gridDim.x * gridDim.y * gridDim.z;
    unsigned sum, cnt, mine, sp = 0u;
    for (;;) {
        sum = 0u; cnt = 0u; mine = 0u;
#pragma unroll
        for (unsigned j = 0; j < 16; ++j) { const unsigned c = xb_ld(&bar[XB_XCNT(j)]); sum += c; cnt += (c > 0u) ? 1u : 0u; mine = (j == x) ? c : mine; }
        if (sum == G) break;
        __builtin_amdgcn_s_sleep(1);
        if ((++sp & 255u) == 0u) { if (xb_ld(&bar[XB_TMO])) break; if (sp > XB_SPIN_CAP) { atomicAdd(&bar[XB_TMO], 1u); break; } }
    }
    nloc = mine > 0u ? mine : 1u; nx = cnt > 0u ? cnt : 1u;
}
__device__ __forceinline__ void xcd_barrier(const XcdBarrier& b) {
    asm volatile("s_waitcnt vmcnt(0)" ::: "memory");
    __syncthreads();
    if (threadIdx.x == 0) {
        unsigned* bar = b.bar;
        __builtin_amdgcn_s_waitcnt(0);
        unsigned nloc = b.st[0], nx = b.st[1];
        if (nloc == 0u) { xcd_barrier_complete(bar, b.x, nloc, nx); b.st[0] = nloc; b.st[1] = nx; }
        const unsigned old = xb_add(&bar[XB_XSUB(b.x)], 1u);
        const unsigned gen = old / nloc;
        if (old + 1u == (gen + 1u) * nloc) {
            __builtin_amdgcn_fence(__ATOMIC_RELEASE, "agent");
            asm volatile("s_waitcnt vmcnt(0)" ::: "memory");
            const unsigned og = xb_add(&bar[XB_TOP], 1u);
            const unsigned tg = og / nx;
            if (og + 1u == (tg + 1u) * nx) xb_add(&bar[XB_TOPGEN], 1u);
            else XB_SPIN(xb_ld(&bar[XB_TOPGEN]) == tg, bar);
            __builtin_amdgcn_fence(__ATOMIC_ACQUIRE, "agent");
            xb_add(&bar[XB_XGEN(b.x)], 1u);
            asm volatile("s_waitcnt vmcnt(0)" ::: "memory");
        } else {
            XB_SPIN(xb_ld(&bar[XB_XGEN(b.x)]) == gen, bar);
            __builtin_amdgcn_fence(__ATOMIC_ACQUIRE, "agent");
            asm volatile("s_waitcnt vmcnt(0)" ::: "memory");
        }
    }
    __syncthreads();
}

struct P0Tile { const float* W; bf16_t* WT; int K, N, mode, row_off, tile; };
__device__ __forceinline__ void p0_tile_load(const P0Tile& t, int tid, f32x4 (&v)[4]) {
    const int nblk = t.N / 64, kb = t.tile / nblk, nb = t.tile % nblk, k0 = 128 * kb, n0 = 64 * nb;
    const int n4 = tid & 15, kr = tid >> 4;
#pragma unroll
    for (int i = 0; i < 4; ++i) v[i] = *(const f32x4*)(t.W + (size_t)(k0 + kr + 32 * i) * t.N + n0 + 4 * n4);
}
__device__ __forceinline__ void p0_tile_finish(const P0Tile& t, int tid, const f32x4 (&v)[4], LAS float* scr) {
    const int nblk = t.N / 64, kb = t.tile / nblk, nb = t.tile % nblk, k0 = 128 * kb, n0 = 64 * nb;
    const int n4 = tid & 15, kr = tid >> 4;
    __syncthreads();
#pragma unroll
    for (int i = 0; i < 4; ++i) { LAS float* d = scr + (kr + 32 * i) * 65 + 4 * n4; d[0] = v[i][0]; d[1] = v[i][1]; d[2] = v[i][2]; d[3] = v[i][3]; }
    __syncthreads();
    int rbase;
    if (t.mode == 0) rbase = t.row_off + n0;
    else rbase = (n0 < DFF) ? (256 * (n0 >> 7) + (n0 & 127)) : (256 * ((n0 - DFF) >> 7) + 128 + ((n0 - DFF) & 127));
    const int n = tid >> 3, c = tid & 7;
    const LAS float* sp = scr + (16 * c) * 65 + n;
    u32x4 o0, o1;
    o0.x = cvt_pk(sp[0 * 65], sp[1 * 65]); o0.y = cvt_pk(sp[2 * 65], sp[3 * 65]); o0.z = cvt_pk(sp[4 * 65], sp[5 * 65]); o0.w = cvt_pk(sp[6 * 65], sp[7 * 65]);
    o1.x = cvt_pk(sp[8 * 65], sp[9 * 65]); o1.y = cvt_pk(sp[10 * 65], sp[11 * 65]); o1.z = cvt_pk(sp[12 * 65], sp[13 * 65]); o1.w = cvt_pk(sp[14 * 65], sp[15 * 65]);
    bf16_t* dp = t.WT + (size_t)(rbase + n) * t.K + k0 + 16 * c;
    *(u32x4*)dp = o0; *(u32x4*)(dp + 8) = o1;
}
__device__ __forceinline__ void rms_row_to_bf16(const float* xrow, const float* g, bf16_t* orow, int lane) {
    const f32x4* xr = (const f32x4*)xrow + lane; const f32x4* gr = (const f32x4*)g + lane;
    f32x4 v[8]; float s = 0.f;
#pragma unroll
    for (int j = 0; j < 8; ++j) { v[j] = xr[64 * j]; s += (v[j][0] * v[j][0] + v[j][1] * v[j][1]) + (v[j][2] * v[j][2] + v[j][3] * v[j][3]); }
    const float rstd = rsqrtf(wave_sum(s) * (1.f / DM) + EPS);
    u32x2* o8 = (u32x2*)orow + lane;
#pragma unroll
    for (int j = 0; j < 8; ++j) { const f32x4 gg = gr[64 * j]; u32x2 w; w.x = cvt_pk(v[j][0] * rstd * gg[0], v[j][1] * rstd * gg[1]); w.y = cvt_pk(v[j][2] * rstd * gg[2], v[j][3] * rstd * gg[3]); o8[64 * j] = w; }
}
__device__ __forceinline__ u32x4 cvt8(const float* p) { const f32x4 a = *(const f32x4*)p, b = *(const f32x4*)(p + 4); u32x4 o; o.x = cvt_pk(a[0], a[1]); o.y = cvt_pk(a[2], a[3]); o.z = cvt_pk(b[0], b[1]); o.w = cvt_pk(b[2], b[3]); return o; }

struct AttnArgs { const bf16_t* Q; int qpitch; int nq; const bf16_t* K; const bf16_t* V; int kvpitch; int ntiles; int j0; const float* table; bf16_t* O; int opitch; };
typedef short v4i16_t __attribute__((ext_vector_type(4)));
__device__ __forceinline__ s16x4 vtr(LAS unsigned char* p) { return __builtin_bit_cast(s16x4, __builtin_amdgcn_ds_read_tr16_b64_v4i16((LAS v4i16_t*)p)); }

__device__ __forceinline__ void attn_dma_tile(const bf16_t* src, int kvpitch, int key0, LAS unsigned char* dst, int lane) {
#pragma unroll
    for (int i = 0; i < 8; ++i) {
        const int row = 4 * i + (lane >> 4), ch = (lane & 15) ^ ((((lane >> 4) & 3) << 2) | (i & 3));
        __builtin_amdgcn_global_load_lds((const unsigned*)(src + (size_t)(key0 + row) * kvpitch + ch * 8), (LAS unsigned*)(dst + i * 1024), 16, 0, 0);
    }
}
__device__ __forceinline__ void attn_unit(LAS unsigned char* lds, const AttnArgs a) {
    int tid_ = threadIdx.x; asm volatile("" : "+v"(tid_));
    const int tid = tid_, lane = tid & 63, r32 = lane & 31, hi = lane >> 5;
    const int wave = __builtin_amdgcn_readfirstlane(tid >> 6);
    const int qh = wave & 1, g = wave >> 1;
    LAS float* tab = (LAS float*)(lds + ATT_TAB);
    LAS float* lsm = (LAS float*)(lds + ATT_LSM);
    LAS unsigned char* myr = lds + wave * ATT_REGION;
    const int nit = (a.ntiles + 3) >> 2;
    const bf16_t* dsrc = qh ? a.V : a.K;
    __syncthreads();
    if (a.table) { tab[tid] = a.table[tid] * LOG2E; if (tid < 320) tab[512 + tid] = a.table[512] * LOG2E; }
    bf16x8 qf[8];
    { const bf16_t* qp = a.Q + (size_t)(qh * 32 + r32) * a.qpitch + hi * 8;
#pragma unroll
      for (int s = 0; s < 8; ++s) qf[s] = *(const bf16x8*)(qp + 16 * s); }
    if (g < a.ntiles) attn_dma_tile(dsrc, a.kvpitch, g * 32, lds + g * 16384 + qh * 8192, lane);
    asm volatile("s_waitcnt vmcnt(0)" ::: "memory");
    __syncthreads();
    f32x16 o[4];
#pragma unroll
    for (int c = 0; c < 4; ++c)
#pragma unroll
        for (int r = 0; r < 16; ++r) o[c][r] = 0.f;
    float lsum = 0.f;
    const int iq = qh * 32 + r32;
    const int q4 = (lane & 15) >> 2, p4 = lane & 3, blk = (lane >> 4) & 1;
    for (int it = 0; it < nit; ++it) {
        const int kt = 4 * it + g;
        if ((kt + 4) < a.ntiles) attn_dma_tile(dsrc, a.kvpitch, (kt + 4) * 32, lds + ((it + 1) & 1) * 65536 + g * 16384 + qh * 8192, lane);
        if (kt < a.ntiles) {
            const int key0 = kt * 32;
            LAS unsigned char* kb = lds + (it & 1) * 65536 + g * 16384;
            LAS unsigned char* vb = kb + 8192;
            f32x16 sacc;
#pragma unroll
            for (int r = 0; r < 16; ++r) sacc[r] = 0.f;
            __builtin_amdgcn_s_setprio(1);
#pragma unroll
            for (int s = 0; s < 8; ++s) { const bf16x8 kf = *(const LAS bf16x8*)(kb + off_b(r32, 2 * s + hi)); sacc = __builtin_amdgcn_mfma_f32_32x32x16_bf16(kf, qf[s], sacc, 0, 0, 0); }
            __builtin_amdgcn_s_setprio(0);
            float p[16];
            const bool far_tile = (qh * 32 + 512 - (a.j0 + key0 + 31)) >= 256;
            if (!a.table || far_tile) {
                const float cbias = a.table ? tab[512] : 0.f;
#pragma unroll
                for (int r = 0; r < 16; ++r) { p[r] = __builtin_amdgcn_exp2f(sacc[r] + cbias); lsum += p[r]; }
            } else {
                const LAS float* tp = tab + (iq + 768 - (a.j0 + key0 + 4 * hi) - 27);
#pragma unroll
                for (int r = 0; r < 16; ++r) { p[r] = __builtin_amdgcn_exp2f(sacc[r] + tp[27 - ((r & 3) + 8 * (r >> 2))]); lsum += p[r]; }
            }
            bf16x8 pf[2];
#pragma unroll
            for (int s2 = 0; s2 < 2; ++s2) { u32x4 w; w.x = cvt_pk(p[8 * s2 + 0], p[8 * s2 + 1]); w.y = cvt_pk(p[8 * s2 + 2], p[8 * s2 + 3]); w.z = cvt_pk(p[8 * s2 + 4], p[8 * s2 + 5]); w.w = cvt_pk(p[8 * s2 + 6], p[8 * s2 + 7]); pf[s2] = __builtin_bit_cast(bf16x8, w); }
            s16x4 vlo[8], vhi[8];
#pragma unroll
            for (int c = 0; c < 4; ++c)
#pragma unroll
                for (int s2 = 0; s2 < 2; ++s2) {
                    const unsigned r0a = 16 * s2 + 4 * hi, chn = 4 * c + 2 * blk + (p4 >> 1);
                    const unsigned a0 = (unsigned)(size_t)(vb + off_b(r0a + q4, chn) + 8 * (p4 & 1)), a1 = (unsigned)(size_t)(vb + off_b(r0a + 8 + q4, chn) + 8 * (p4 & 1));
                    asm volatile("ds_read_b64_tr_b16 %0, %1" : "=&v"(vlo[c * 2 + s2]) : "v"(a0) : "memory");
                    asm volatile("ds_read_b64_tr_b16 %0, %1" : "=&v"(vhi[c * 2 + s2]) : "v"(a1) : "memory");
                }
            asm volatile("s_waitcnt lgkmcnt(0)" ::: "memory");
            __builtin_amdgcn_sched_barrier(0);
#pragma unroll
            for (int c = 0; c < 4; ++c)
#pragma unroll
                for (int s2 = 0; s2 < 2; ++s2) {
                    const s16x4 lo = vlo[c * 2 + s2], h4 = vhi[c * 2 + s2];
                    const bf16x8 vf = (bf16x8){lo[0], lo[1], lo[2], lo[3], h4[0], h4[1], h4[2], h4[3]};
                    o[c] = __builtin_amdgcn_mfma_f32_32x32x16_bf16(vf, pf[s2], o[c], 0, 0, 0);
                }
        }
        asm volatile("s_waitcnt vmcnt(0) lgkmcnt(0)" ::: "memory");
        __syncthreads();
    }
    lsum += __shfl_xor(lsum, 32);
#pragma unroll
    for (int c = 0; c < 4; ++c)
#pragma unroll
        for (int r4 = 0; r4 < 4; ++r4) { const int d0 = 32 * c + 8 * r4 + 4 * hi;
            *(LAS f32x4*)(myr + (r32 * 132 + d0) * 4) = (f32x4){o[c][4 * r4 + 0], o[c][4 * r4 + 1], o[c][4 * r4 + 2], o[c][4 * r4 + 3]}; }
    if (hi == 0) lsm[wave * 32 + r32] = lsum;
    __syncthreads();
    { const int q = tid >> 3;
      if (q < a.nq) { const int qh2 = q >> 5, ql = q & 31, d0 = (tid & 7) * 16;
        f32x4 s0 = (f32x4){0.f, 0.f, 0.f, 0.f}, s1 = s0, s2 = s0, s3 = s0; float lt = 0.f;
#pragma unroll
        for (int gg = 0; gg < 4; ++gg) { const int w2 = gg * 2 + qh2; const LAS f32x4* rp = (const LAS f32x4*)(lds + w2 * ATT_REGION + (ql * 132 + d0) * 4);
            s0 += rp[0]; s1 += rp[1]; s2 += rp[2]; s3 += rp[3]; lt += lsm[w2 * 32 + ql]; }
        const float inv = 1.f / lt;
        u32x4 w0, w1;
        w0.x = cvt_pk(s0[0] * inv, s0[1] * inv); w0.y = cvt_pk(s0[2] * inv, s0[3] * inv); w0.z = cvt_pk(s1[0] * inv, s1[1] * inv); w0.w = cvt_pk(s1[2] * inv, s1[3] * inv);
        w1.x = cvt_pk(s2[0] * inv, s2[1] * inv); w1.y = cvt_pk(s2[2] * inv, s2[3] * inv); w1.z = cvt_pk(s3[0] * inv, s3[1] * inv); w1.w = cvt_pk(s3[2] * inv, s3[3] * inv);
        bf16_t* op = a.O + (size_t)q * a.opitch + d0;
        *(u32x4*)op = w0; *(u32x4*)(op + 8) = w1; } }
}

struct LruArgs { const bf16_t* Zrow0; int T; const float* conv_past; const float* h0; int n; int nb; bf16_t* MIXrow0; float* out_bh; };
__device__ __forceinline__ int tokmap(int rho) { return 16 * ((rho >> 2) & 1) + (rho & 3) + 4 * (rho >> 3); }

__device__ __forceinline__ void lru_unit(LAS unsigned char* lds, const LruArgs a, const Args& args) {
    typedef float f32x2 __attribute__((ext_vector_type(2)));
    int tid_ = threadIdx.x; asm volatile("" : "+v"(tid_));
    const int tid = tid_, lane = tid & 63, r32 = lane & 31, hi = lane >> 5;
    const int wave = __builtin_amdgcn_readfirstlane(tid >> 6);
    LAS float* xct = (LAS float*)(lds + LRU_XCT + wave * 8192);
    LAS f32x2* agg = (LAS f32x2*)(lds + LRU_AGG);
    LAS float* cwl = (LAS float*)(lds + LRU_CW);
    const int n = a.n;
    __syncthreads();
    if (tid < 256) cwl[tid] = args.in[19][(tid >> 6) * 512 + 64 * n + (tid & 63)];
    else if (tid < 320) cwl[tid] = args.in[20][64 * n + (tid - 256)];
    __syncthreads();
    LAS unsigned char* wl = lds + LRU_W;
#pragma unroll
    for (int ff = 0; ff < 2; ++ff) {
        const int f = wave + 8 * ff, gate = f >> 3, s = (f >> 1) & 3, nb = f & 1;
        const float* pw = (gate ? args.in[23] : args.in[21]) + (size_t)n * 4096 + (size_t)(16 * s + 8 * hi) * 64 + 32 * nb + r32;
        u32x4 uw; uw.x = cvt_pk(pw[0], pw[64]); uw.y = cvt_pk(pw[128], pw[192]); uw.z = cvt_pk(pw[256], pw[320]); uw.w = cvt_pk(pw[384], pw[448]);
        *(LAS u32x4*)(wl + (f * 64 + lane) * 16) = uw;
    }
    __syncthreads();
    const int nb = a.nb;
    const int chn = 64 * n + 32 * nb + r32;
    const float ba = args.in[22][chn], bi = args.in[24][chn], cl = -8.0f * log1pf(__expf(-args.in[25][chn]));
    float hsb = a.h0 ? a.h0[chn] : 0.f;
    const int nsb = (a.T + 255) >> 8;
    int par = 0;
    const int tl = tokmap(r32);
    u32x4 xw[4][4];
#define LRU_LOAD_X(SB) do { const int t0n_ = (SB) * 256 + 32 * wave; if (t0n_ < a.T) { const int tau_ = t0n_ + tl; \
        _Pragma("unroll") for (int s = 0; s < 4; ++s) _Pragma("unroll") for (int k = 0; k < 4; ++k) { const int tr = tau_ - 3 + k; const int ch0 = 16 * s + 8 * hi; \
            if (tr >= 0) xw[s][k] = *(const u32x4*)(a.Zrow0 + (size_t)tr * DIN + 3584 + 64 * n + ch0); \
            else if (a.conv_past) xw[s][k] = cvt8(a.conv_past + (size_t)(tr + 3) * 512 + 64 * n + ch0); \
            else xw[s][k] = (u32x4){0u, 0u, 0u, 0u}; } } } while (0)
    LRU_LOAD_X(0);
    for (int sb = 0; sb < nsb; ++sb) {
        const int t0 = sb * 256 + 32 * wave;
        const bool active = t0 < a.T;
        float hl[16], ac[16];
        bf16_t gw[16];
        if (active) {
#pragma unroll
            for (int r = 0; r < 16; ++r) gw[r] = a.Zrow0[(size_t)(t0 + 16 * hi + r) * DIN + 4096 + chn];
            bf16x8 af[4];
#pragma unroll
            for (int s = 0; s < 4; ++s) {
                const int ch0 = 16 * s + 8 * hi;
                float xc[8];
#pragma unroll
                for (int e = 0; e < 8; ++e) xc[e] = cwl[256 + ch0 + e];
#pragma unroll
                for (int k = 0; k < 4; ++k) {
                    const u32x4 w = xw[s][k];
                    const float xv[8] = {bf_lo(w.x), bf_hi(w.x), bf_lo(w.y), bf_hi(w.y), bf_lo(w.z), bf_hi(w.z), bf_lo(w.w), bf_hi(w.w)};
#pragma unroll
                    for (int e = 0; e < 8; ++e) xc[e] += cwl[k * 64 + ch0 + e] * xv[e];
                }
                *(LAS f32x4*)(xct + tl * 64 + ch0) = (f32x4){xc[0], xc[1], xc[2], xc[3]};
                *(LAS f32x4*)(xct + tl * 64 + ch0 + 4) = (f32x4){xc[4], xc[5], xc[6], xc[7]};
                u32x4 w; w.x = cvt_pk(xc[0], xc[1]); w.y = cvt_pk(xc[2], xc[3]); w.z = cvt_pk(xc[4], xc[5]); w.w = cvt_pk(xc[6], xc[7]);
                af[s] = __builtin_bit_cast(bf16x8, w);
            }
            LRU_LOAD_X(sb + 1);
            asm volatile("s_waitcnt lgkmcnt(0)" ::: "memory");
            f32x16 za, zi;
#pragma unroll
            for (int r = 0; r < 16; ++r) { za[r] = 0.f; zi[r] = 0.f; }
#pragma unroll
            for (int s = 0; s < 4; ++s) { const bf16x8 fa = *(const LAS bf16x8*)(wl + ((s * 2 + nb) * 64 + lane) * 16), fi = *(const LAS bf16x8*)(wl + ((8 + s * 2 + nb) * 64 + lane) * 16);
                za = __builtin_amdgcn_mfma_f32_32x32x16_bf16(af[s], fa, za, 0, 0, 0); zi = __builtin_amdgcn_mfma_f32_32x32x16_bf16(af[s], fi, zi, 0, 0, 0); }
            float hrun = 0.f, arun = 1.f;
#pragma unroll
            for (int r = 0; r < 16; ++r) {
                const float xcv = xct[(16 * hi + r) * 64 + 32 * nb + r32];
                const float rg = sigmoidf_(za[r] + ba), ig = sigmoidf_(zi[r] + bi);
                const float la = rg * cl;
                const float av = __builtin_amdgcn_exp2f(la * LOG2E);
                const float mult = __builtin_amdgcn_sqrtf(fmaxf(1.f - av * av, 0.f));
                const float uu = mult * (ig * xcv);
                hrun = av * hrun + uu; arun *= av;
                hl[r] = hrun; ac[r] = arun;
            }
            agg[(par * 16 + 2 * wave + hi) * 32 + r32] = (f32x2){arun, hrun};
        } else {
            agg[(par * 16 + 2 * wave + hi) * 32 + r32] = (f32x2){1.f, 0.f};
        }
        __syncthreads();
        float hin = 0.f;
        { float run = hsb;
#pragma unroll
          for (int sg = 0; sg < 16; ++sg) { const f32x2 ab = agg[(par * 16 + sg) * 32 + r32]; if (sg == 2 * wave + hi) hin = run; run = ab.x * run + ab.y; }
          hsb = run; }
        if (active) {
#pragma unroll
            for (int r = 0; r < 16; ++r) {
                const float h = hl[r] + ac[r] * hin;
                const int t = t0 + 16 * hi + r;
                const float ov = h * gelu_tanh(bf1(gw[r]));
                a.MIXrow0[(size_t)t * DM + 1536 + chn] = (bf16_t)(cvt_pk(ov, 0.f) & 0xffffu);
            }
        }
        par ^= 1;
    }
#undef LRU_LOAD_X
    if (wave == 0 && hi == 0) a.out_bh[chn] = hsb;
}

__global__ void __launch_bounds__(512) fwd_megakernel(Args args) {
    extern __shared__ __attribute__((aligned(16))) unsigned char lds_raw[];
    LAS unsigned char* lds = (LAS unsigned char*)lds_raw;
    cg::grid_group grid = cg::this_grid();
    const int tid = threadIdx.x, lane = tid & 63, wave = __builtin_amdgcn_readfirstlane(tid >> 6);
    const int G = gridDim.x, bx = blockIdx.x;
    unsigned char* ws = args.ws; float* out = args.out;
#define ctl ((unsigned*)(ws + WS_CTL))
#define ssq ((float*)(ws + WS_CTL) + CW_SSQ)
#define WIN ((bf16_t*)(ws + WS_WIN))
#define WOUT ((bf16_t*)(ws + WS_WOUT))
#define WUP ((bf16_t*)(ws + WS_WUP))
#define WDN ((bf16_t*)(ws + WS_WDN))
#define A1 ((bf16_t*)(ws + WS_A1))
#define XG ((bf16_t*)(ws + WS_A1))
#define Z ((bf16_t*)(ws + WS_Z))
#define H ((bf16_t*)(ws + WS_Z))
#define ZM ((bf16_t*)(ws + WS_ZM))
#define MIX ((bf16_t*)(ws + WS_MIX))
#define KS ((bf16_t*)(ws + WS_KS))
#define VS ((bf16_t*)(ws + WS_VS))
#define MKP ((bf16_t*)(ws + WS_MKP))
#define MVP ((bf16_t*)(ws + WS_MVP))
#define MKS ((bf16_t*)(ws + WS_MKS))
#define MVS ((bf16_t*)(ws + WS_MVS))
#define UB ((float*)(ws + WS_UB))
#define x_prompt (args.in[0])
#define x_sample (args.in[1])
    const int gw = bx * 8 + wave, NGW = G * 8;
    if (tid < 16) ((LAS unsigned*)(lds + MISC_OFF))[tid] = 0u;
    __syncthreads();
    const XcdBarrier xbar = xcd_barrier_post(ctl + CW_BAR, (volatile LAS unsigned*)(lds + MISC_OFF) + 8);

#ifndef REP0
#define REP0 1
#endif
    for (int rep0 = 0; rep0 < REP0; ++rep0) {
        if (rep0) grid.sync();
        LAS float* scr = (LAS float*)lds;
        constexpr int T_IN = 16 * 72, T_MEM = 16 * 16, T_OUT = 16 * 32, T_UP = 16 * 192, T_DN = 48 * 32;
        constexpr int NTILES = T_IN + T_MEM + T_OUT + T_UP + T_DN;
        auto decode = [&](int it) -> P0Tile {
            int r = it; P0Tile t;
            if (r < T_UP) { t = P0Tile{args.in[28], WUP, DM, DUP, 1, 0, r}; return t; } r -= T_UP;
            if (r < T_DN) { t = P0Tile{args.in[31], WDN, DFF, DM, 0, 0, r}; return t; } r -= T_DN;
            if (r < T_IN) { t = P0Tile{args.in[11], WIN, DM, DIN, 0, 0, r}; return t; } r -= T_IN;
            if (r < T_OUT) { t = P0Tile{args.in[26], WOUT, DM, DM, 0, 0, r}; return t; } r -= T_OUT;
            t = P0Tile{args.in[18], WIN, DM, 1024, 0, DIN, r}; return t;
        };
        if (bx < NTILES) {
            P0Tile cur = decode(bx); f32x4 v[4]; p0_tile_load(cur, tid, v);
            for (int it = bx; it < NTILES; it += G) {
                const bool more = it + G < NTILES;
                P0Tile nxt = cur; f32x4 vn[4];
                if (more) { nxt = decode(it + G); p0_tile_load(nxt, tid, vn); }
                p0_tile_finish(cur, tid, v, scr);
                if (more) { cur = nxt;
#pragma unroll
                    for (int i = 0; i < 4; ++i) v[i] = vn[i]; }
            }
        }
        for (int m = gw; m < MA1; m += NGW) {
            const float* xr; const float* g;
            if (m < MP) { xr = x_prompt + (size_t)m * DM; g = args.in[10]; }
            else if (m < MT) { xr = x_sample + (size_t)(m - MP) * DM; g = args.in[10]; }
            else { xr = args.in[9] + (size_t)(m - MT) * DM; g = args.in[17]; }
            rms_row_to_bf16(xr, g, A1 + (size_t)m * DM, lane);
        }
    }
    if (args.ws == nullptr) grid.sync();
    xcd_barrier(xbar);

    {
        pg8::Gemm g{A1, WIN, nullptr, 1 << 20}; typedef pg8::SchedT<66, 18, 32, 16, 66, 18, 4, 0, 0, 1> S1; S1 S{G, bx, nullptr, nullptr};
        pg8::EpiZ E{ws, out, &args.in[12]};
        pg8::gemm_phase<pg8::EpiZ, false, S1, DM>(lds, g, S, E);
        {
            LAS unsigned* misc = (LAS unsigned*)(lds + MISC_OFF);
            constexpr int C_AK = 16 * 512 * 1024 / 8, C_MK = 16 * 256 * 512 / 8, C_TOT = 2 * C_AK + 2 * C_MK, NGRP = C_TOT / 2048;
            for (;;) {
                __syncthreads();
                if (tid == 0) misc[0] = atomicAdd(ctl + CW_QCONV, 1u);
                __syncthreads();
                const int grp = (int)misc[0];
                if (grp >= NGRP) break;
                const float* src[4]; bf16_t* dst[4]; f32x4 va[4], vb[4];
#pragma unroll
                for (int u = 0; u < 4; ++u) {
                    int r = grp * 2048 + u * 512 + tid;
                    if (r < 2 * C_AK) { const int which = r >= C_AK; if (which) r -= C_AK;
                        const size_t e = (size_t)r * 8; const int sq = (int)(e >> 19), rem = (int)(e & 524287);
                        src[u] = (which ? args.in[3] : args.in[2]) + e; dst[u] = (which ? VS : KS) + (size_t)sq * 544 * 1024 + rem; }
                    else { r -= 2 * C_AK; const int which = r >= C_MK; if (which) r -= C_MK; const size_t e = (size_t)r * 8;
                        src[u] = (which ? args.in[5] : args.in[4]) + e; dst[u] = (which ? MVS : MKS) + e; }
                    va[u] = *(const f32x4*)src[u]; vb[u] = *(const f32x4*)(src[u] + 4);
                }
#pragma unroll
                for (int u = 0; u < 4; ++u) { u32x4 o; o.x = cvt_pk(va[u][0], va[u][1]); o.y = cvt_pk(va[u][2], va[u][3]); o.z = cvt_pk(vb[u][0], vb[u][1]); o.w = cvt_pk(vb[u][2], vb[u][3]); *(u32x4*)dst[u] = o; }
            }
        }
    }
    xcd_barrier(xbar);

#ifndef REP2
#define REP2 1
#endif
    for (int rep2 = 0; rep2 < REP2; ++rep2) {
        if (rep2) grid.sync();
        LAS unsigned* misc = (LAS unsigned*)(lds + MISC_OFF);
        constexpr int N_LP = 64, N_LS = 256, N_AS = 128, N_MS = 64, N_GS = 16, N_AP = 2048, N_MPp = 1024;
        constexpr int N_GU = 96, POS_GU = N_LP + N_LS + N_AS + N_MS + N_GS + 1500;
        constexpr int NITEMS = N_LP + N_LS + N_AS + N_MS + N_GS + N_AP + N_MPp + N_GU;
        constexpr unsigned N_SAMPLE_ITEMS = N_LS + N_AS + N_MS;
        for (;;) {
            __syncthreads();
            if (tid == 0) misc[0] = atomicAdd(ctl + CW_QUEUE + 64 * rep2, 1u);
            __syncthreads();
            int it = (int)misc[0];
            if (it >= NITEMS) break;
            bool sample_item = false; bool gs_item = false;
            if (it >= POS_GU && it < POS_GU + N_GU) {
                const int j = it - POS_GU;
                if (tid == 0) { while (__hip_atomic_load(ctl + CW_UDONE, __ATOMIC_RELAXED, __HIP_MEMORY_SCOPE_AGENT) < (unsigned)N_GS) __builtin_amdgcn_s_sleep(8); __threadfence(); }
                __syncthreads();
                pg8::Gemm g{XG, WUP, nullptr, 1 << 20}; pg8::SchedOne S{64 + j / 48, j % 48, 32, nullptr, nullptr};
                pg8::EpiUp E{ssq, args.in[29], args.in[30], args.in[8], out, H, UB, (bf16_t*)(ws + WS_HS)};
                pg8::gemm_phase<pg8::EpiUp, true, pg8::SchedOne, DM>(lds, g, S, E);
                continue;
            }
            if (it >= POS_GU + N_GU) it -= N_GU;
            if (it < N_LP + N_LS) {
                LruArgs a;
                if (it < N_LP) { const int b = it >> 4; a.n = (it >> 1) & 7; a.nb = it & 1; a.Zrow0 = Z + (size_t)b * 4096 * DIN; a.T = 4096; a.conv_past = nullptr; a.h0 = nullptr;
                    a.MIXrow0 = MIX + (size_t)b * 4096 * DM; a.out_bh = out + O_BHP + b * 512; }
                else { const int i2 = it - N_LP, s = i2 >> 4; a.n = (i2 >> 1) & 7; a.nb = i2 & 1; a.Zrow0 = Z + (size_t)(MP + 32 * s) * DIN; a.T = 32; a.conv_past = args.in[6] + (size_t)s * 3 * 512; a.h0 = args.in[7] + (size_t)s * 512;
                    a.MIXrow0 = MIX + (size_t)(MP + 32 * s) * DM; a.out_bh = out + O_BHS + s * 512; sample_item = true; }
                lru_unit(lds, a, args);
            } else if (it >= N_LP + N_LS + N_AS + N_MS && it < N_LP + N_LS + N_AS + N_MS + N_GS) {
                const int j = it - (N_LP + N_LS + N_AS + N_MS);
                if (tid == 0) { while (__hip_atomic_load(ctl + CW_SDONE, __ATOMIC_RELAXED, __HIP_MEMORY_SCOPE_AGENT) < N_SAMPLE_ITEMS) __builtin_amdgcn_s_sleep(8); __threadfence(); }
                __syncthreads();
                pg8::Gemm g{MIX, WOUT, nullptr, 1 << 20}; pg8::SchedOne S{64 + (j >> 3), j & 7, 32, nullptr, nullptr};
                pg8::EpiOut E{x_prompt, x_sample, out + O_Y, XG, args.in[27], ssq};
                pg8::gemm_phase<pg8::EpiOut, false, pg8::SchedOne, DM>(lds, g, S, E);
                gs_item = true;
            } else {
                AttnArgs a;
                if (it < N_LP + N_LS + N_AS) { const int i2 = it - N_LP - N_LS; const int h = i2 & 7, s = i2 >> 3; const int row = MP + 32 * s; sample_item = true;
                    a.Q = Z + (size_t)row * DIN + 128 * h; a.qpitch = DIN; a.nq = 32; a.K = KS + (size_t)s * 544 * 1024 + 128 * h; a.V = VS + (size_t)s * 544 * 1024 + 128 * h; a.kvpitch = 1024;
                    a.ntiles = 17; a.j0 = 0; a.table = args.in[14] + h * 513; a.O = MIX + (size_t)row * DM + 128 * h; a.opitch = DM; }
                else if (it < N_LP + N_LS + N_AS + N_MS) { const int i2 = it - N_LP - N_LS - N_AS; const int hm = i2 & 3, s = i2 >> 2; const int row = MP + 32 * s; sample_item = true;
                    a.Q = Z + (size_t)row * DIN + 3072 + 128 * hm; a.qpitch = DIN; a.nq = 32; a.K = MKS + (size_t)s * 256 * 512 + 128 * hm; a.V = MVS + (size_t)s * 256 * 512 + 128 * hm; a.kvpitch = 512;
                    a.ntiles = 8; a.j0 = 0; a.table = nullptr; a.O = MIX + (size_t)row * DM + 1024 + 128 * hm; a.opitch = DM; }
                else if (it < N_LP + N_LS + N_AS + N_MS + N_GS + N_AP) { const int i2 = it - (N_LP + N_LS + N_AS + N_MS + N_GS); const int h = i2 & 7, c = (i2 >> 3) & 63, b = i2 >> 9; const int row = b * 4096 + 64 * c, cb = c < 8 ? c : 8, krow = row - 64 * cb;
                    a.Q = Z + (size_t)row * DIN + 128 * h; a.qpitch = DIN; a.nq = 64; a.K = Z + (size_t)krow * DIN + 1024 + 128 * h; a.V = Z + (size_t)krow * DIN + 2048 + 128 * h; a.kvpitch = DIN;
                    a.ntiles = 2 * (cb + 1); a.j0 = 512 - 64 * cb; a.table = args.in[14] + h * 513; a.O = MIX + (size_t)row * DM + 128 * h; a.opitch = DM; }
                else { const int i2 = it - (N_LP + N_LS + N_AS + N_MS + N_GS + N_AP); const int hm = i2 & 3, c = (i2 >> 2) & 63, b = i2 >> 8; const int row = b * 4096 + 64 * c;
                    a.Q = Z + (size_t)row * DIN + 3072 + 128 * hm; a.qpitch = DIN; a.nq = 64; a.K = MKP + (size_t)b * 256 * 512 + 128 * hm; a.V = MVP + (size_t)b * 256 * 512 + 128 * hm; a.kvpitch = 512;
                    a.ntiles = 8; a.j0 = 0; a.table = nullptr; a.O = MIX + (size_t)row * DM + 1024 + 128 * hm; a.opitch = DM; }
                attn_unit(lds, a);
            }
            if (sample_item || gs_item) {
                asm volatile("s_waitcnt vmcnt(0)" ::: "memory");
                __syncthreads();
                if (tid == 0) { __threadfence(); __hip_atomic_fetch_add(ctl + (gs_item ? CW_UDONE : CW_SDONE), 1u, __ATOMIC_RELAXED, __HIP_MEMORY_SCOPE_AGENT); }
            }
        }
    }
    xcd_barrier(xbar);

    {
        pg8::Gemm g{MIX, WOUT, nullptr, 1 << 20}; typedef pg8::SchedT<64, 8, 32, 0, 0, 0, 1, 0, 0, 1> S3; S3 S{G, bx, nullptr, nullptr};
        pg8::EpiOut E{x_prompt, x_sample, out + O_Y, XG, args.in[27], ssq};
        pg8::gemm_phase<pg8::EpiOut, false, S3, DM>(lds, g, S, E);
    }
    xcd_barrier(xbar);

    {
        pg8::Gemm g{XG, WUP, nullptr, 1 << 20}; typedef pg8::SchedT<64, 48, 32, 0, 0, 0, 1, 0, 0, 1> S4; S4 S{G, bx, nullptr, nullptr};
        pg8::EpiUp E{ssq, args.in[29], args.in[30], args.in[8], out, H, UB, (bf16_t*)(ws + WS_HS)};
        pg8::gemm_phase<pg8::EpiUp, true, S4, DM>(lds, g, S, E);
    }
    xcd_barrier(xbar);

    {
        const float* cfw = args.in[29]; const float* cfb = args.in[30];
        const int gt = bx * 512 + tid, NGT = G * 512;
        constexpr int NJ = 128 * 2 * (DFF / 4);
        for (int j = gt; j < NJ; j += NGT) {
            const int c4 = j % (DFF / 4), tt = (j / (DFF / 4)) & 1, bnd = j / (2 * (DFF / 4));
            if ((bnd & 31) == 0) continue;
            const int kap = c4 * 4;
            f32x4 yv[2];
#pragma unroll
            for (int bj = 0; bj < 2; ++bj) { const int col = bj * DFF + kap;
                const f32x4 w0 = *(const f32x4*)(cfw + col), w1 = *(const f32x4*)(cfw + DUP + col), w2 = *(const f32x4*)(cfw + 2 * DUP + col), cb = *(const f32x4*)(cfb + col);
                const f32x4 u0 = *(const f32x4*)(UB + ((size_t)(bnd * 4 + tt) * 2 + bj) * DFF + kap), u1 = *(const f32x4*)(UB + ((size_t)(bnd * 4 + tt + 1) * 2 + bj) * DFF + kap),
                            u2 = *(const f32x4*)(UB + ((size_t)(bnd * 4 + tt + 2) * 2 + bj) * DFF + kap);
                yv[bj] = cb + w0 * u0 + w1 * u1 + w2 * u2; }
            u32x2 w; w.x = cvt_pk(gelu_tanh(yv[1][0]) * yv[0][0], gelu_tanh(yv[1][1]) * yv[0][1]); w.y = cvt_pk(gelu_tanh(yv[1][2]) * yv[0][2], gelu_tanh(yv[1][3]) * yv[0][3]);
            *(u32x2*)(H + (size_t)(128 * bnd + tt) * DFF + kap) = w;
        }
    }
    xcd_barrier(xbar);

    {
        pg8::Gemm g{H, WDN, (const bf16_t*)(ws + WS_HS), 64}; typedef pg8::SchedT<64, 8, 96, 0, 0, 0, 1, 16, 64, 8> S5; S5 S{G, bx, (float*)(ws + WS_END), ctl + CW_CNT5};
        pg8::EpiDown E{out + O_Y};
        pg8::gemm_phase<pg8::EpiDown, false, S5, DFF>(lds, g, S, E);
    }
}

extern "C" void kernel_launch(void* const* d_in, const int* in_sizes, int n_in, void* d_out, int out_size, void* d_ws, size_t ws_size, hipStream_t stream) {
    static int grid = 0;
    if (grid == 0) {
        if (n_in != 32 || ws_size < WS_END + 48 * MiB) { fprintf(stderr, "kernel_launch: n_in %d ws %zu (need 32, >= %zu)\n", n_in, ws_size, (size_t)WS_END); grid = -1; return; }
        int dev = 0, cus = 0, per_cu = 0;
        hipGetDevice(&dev); hipDeviceGetAttribute(&cus, hipDeviceAttributeMultiprocessorCount, dev);
        if (hipFuncSetAttribute((const void*)fwd_megakernel, hipFuncAttributeMaxDynamicSharedMemorySize, LDS_BYTES) != hipSuccess) { fprintf(stderr, "kernel_launch: hipFuncSetAttribute failed\n"); grid = -1; return; }
        if (hipOccupancyMaxActiveBlocksPerMultiprocessor(&per_cu, (const void*)fwd_megakernel, 512, LDS_BYTES) != hipSuccess || per_cu < 1) { fprintf(stderr, "kernel_launch: occupancy query says %d\n", per_cu); per_cu = 1; }
        (void)hipGetLastError();
        grid = cus * 1;
    }
    if (grid < 0) return;
    hipMemsetAsync((char*)d_ws + WS_CTL, 0, CTL_BYTES, stream);
    Args a{};
    for (int i = 0; i < 32; ++i) a.in[i] = (const float*)d_in[i];
    a.out = (float*)d_out; a.ws = (unsigned char*)d_ws;
    void* kargs[] = {&a};
    hipError_t e = hipLaunchCooperativeKernel((const void*)fwd_megakernel, dim3(grid), dim3(512), kargs, LDS_BYTES, stream);
    if (e != hipSuccess) fprintf(stderr, "cooperative launch failed: %s (grid %d)\n", hipGetErrorString(e), grid);
}
```

```cpp
#include <hip/hip_runtime.h>
#include <hip/hip_cooperative_groups.h>
#include <cstdio>
#include <cstdint>
namespace cg = cooperative_groups;

#define LAS __attribute__((address_space(3)))
typedef unsigned short bf16_t;
typedef short bf16x8 __attribute__((ext_vector_type(8)));
typedef short s16x4 __attribute__((ext_vector_type(4)));
typedef float f32x4 __attribute__((ext_vector_type(4)));
typedef float f32x16 __attribute__((ext_vector_type(16)));
typedef unsigned u32x4 __attribute__((ext_vector_type(4)));
typedef unsigned u32x2 __attribute__((ext_vector_type(2)));

constexpr int DM = 2048, MP = 16384, MS = 512, MT = MP + MS, MMEM = 1024, MA1 = MT + MMEM;
constexpr int DIN = 4608, NINT = DIN + 1024, DFF = 6144, DUP = 12288;
constexpr float EPS = 1e-6f;
constexpr float LOG2E = 1.4426950408889634f;
constexpr float QSCALE = 0.08838834764831845f * LOG2E;
constexpr size_t O_Y = 0, O_AKP = 34603008, O_AVP = 36700160, O_MKP = 38797312, O_MVP = 39321600, O_BCP = 39845888, O_BHP = 39852032,
                 O_FCP = 39854080, O_AKS = 39952384, O_AVS = 40476672, O_BCS = 41000960, O_BHS = 41025536, O_FCS = 41033728;
constexpr size_t MiB = 1u << 20;
constexpr size_t WS_CTL = 0, CTL_BYTES = 1 * MiB;
constexpr size_t WS_WIN = 2 * MiB, WS_WOUT = 24 * MiB, WS_WUP = 32 * MiB, WS_WDN = 80 * MiB;
constexpr size_t WS_A1 = 104 * MiB;
constexpr size_t WS_Z = 174 * MiB;
constexpr size_t WS_ZM = 323 * MiB;
constexpr size_t WS_MIX = 325 * MiB;
constexpr size_t WS_KS = 391 * MiB, WS_VS = 408 * MiB;
constexpr size_t WS_MKP = 425 * MiB, WS_MVP = 426 * MiB, WS_MKS = 427 * MiB, WS_MVS = 431 * MiB;
constexpr size_t WS_UB = 435 * MiB;
constexpr size_t WS_END = 460 * MiB;
constexpr size_t WS_HS = 500 * MiB;
constexpr int CW_QUEUE = 0, CW_CNT3 = 1024, CW_CNT5 = 2048, CW_CNT4 = 3072, CW_BAR = 4096, CW_SDONE = 128, CW_UDONE = 192, CW_QCONV = 256;
constexpr int CW_SSQ = 16384;

__device__ __forceinline__ unsigned cvt_pk(float lo, float hi) { unsigned r; asm volatile("v_cvt_pk_bf16_f32 %0, %1, %2" : "=v"(r) : "v"(lo), "v"(hi)); return r; }
__device__ __forceinline__ float bf_lo(unsigned w) { return __uint_as_float(w << 16); }
__device__ __forceinline__ float bf_hi(unsigned w) { return __uint_as_float(w & 0xffff0000u); }
__device__ __forceinline__ float bf1(bf16_t h) { return __uint_as_float(((unsigned)h) << 16); }
__device__ __forceinline__ float sigmoidf_(float x) { return __builtin_amdgcn_rcpf(1.f + __builtin_amdgcn_exp2f(-LOG2E * x)); }
__device__ __forceinline__ float gelu_tanh(float x) { const float t = (1.5957691216057308f * LOG2E) * (x + 0.044715f * x * x * x); return x * __builtin_amdgcn_rcpf(1.f + __builtin_amdgcn_exp2f(-t)); }
__device__ __forceinline__ int crow(int r, int hi) { return (r & 3) + 8 * (r >> 2) + 4 * hi; }
__device__ __forceinline__ unsigned off_b(unsigned row, unsigned ch) { return 256u * row + 16u * (ch ^ (((row & 3) << 2) | ((row >> 2) & 3))); }
__device__ __forceinline__ float wave_sum(float v) {
#pragma unroll
    for (int o = 1; o < 64; o <<= 1) v += __shfl_xor(v, o);
    return v;
}

namespace pg8 {
constexpr int BM = 256, BK = 64, HALF = 128, HTB = HALF * BK * 2, STAGE_BYTES = 8 * HTB, NXCD = 8, WGM = 8;
__host__ __device__ __forceinline__ int lds_byte(int r, int c) { const int st = (r >> 4) * 2 + (c >> 5), rr = r & 15, cc = c & 31, ob = rr * 64 + cc * 2; return st * 1024 + (ob ^ (((ob >> 9) & 1) << 5)); }
__host__ __device__ __forceinline__ void stage_rc(int b, int& R, int& C) { const int st = b / 1024, sb = b % 1024, swz = sb ^ (((sb >> 9) & 1) << 5); R = (st >> 1) * 16 + swz / 64; C = (st & 1) * 32 + (swz % 64) / 2; }
__host__ __device__ __forceinline__ int perm32(int rho) { const int n = rho >> 4, i = rho & 15; return 8 * (i >> 2) + 4 * n + (i & 3); }

struct Unit { int pm, pn, koff, nt, ks, nsplit, tile; };
struct Gemm { const bf16_t* A; const bf16_t* Bt; const bf16_t* A2; int pm2; };

template <int NM, int NN, int NT, int NEXTRA, int EX_PM0, int EX_PN0, int EX_W, int SP_TILES, int SP_PM0, int SP_SPLIT>
struct SchedT {
    static constexpr int nwg = NM * NN, sp_count = SP_TILES * SP_SPLIT, sp_nt = NT / SP_SPLIT;
    int G, c; float* part; unsigned* cnt;
    __device__ __forceinline__ bool next(int i, Unit& u) const {
        int L = i * G + c; if (L >= sp_count + nwg + NEXTRA) return false;
        u.koff = 0; u.nt = NT; u.ks = 0; u.nsplit = 1; u.tile = 0;
        if (SP_TILES > 0 && L < sp_count) { const int tile = L / SP_SPLIT, ks = L % SP_SPLIT; u.pm = SP_PM0 + tile / NN; u.pn = tile % NN; u.koff = ks * sp_nt * BK; u.nt = sp_nt; u.ks = ks; u.nsplit = SP_SPLIT; u.tile = tile; return true; }
        L -= sp_count;
        if (NEXTRA > 0 && L >= nwg) { const int e = L - nwg; u.pm = EX_PM0 + e / EX_W; u.pn = EX_PN0 + e % EX_W; return true; }
        int wgid = L; { constexpr int q = nwg / NXCD, r = nwg % NXCD; const int xcd = wgid % NXCD, off = wgid / NXCD; wgid = (xcd < r ? xcd * (q + 1) : r * (q + 1) + (xcd - r) * q) + off; }
        constexpr int nig = WGM * NN; const int gid = wgid / nig, fm = gid * WGM, gsz = (NM - fm) < WGM ? (NM - fm) : WGM;
        u.pm = fm + ((wgid % nig) % gsz); u.pn = (wgid % nig) / gsz; return true;
    }
};

struct SchedOne {
    int pm, pn, nt; float* part; unsigned* cnt;
    __device__ __forceinline__ bool next(int i, Unit& u) const { if (i > 0) return false; u.pm = pm; u.pn = pn; u.koff = 0; u.nt = nt; u.ks = 0; u.nsplit = 1; u.tile = 0; return true; }
};

template <class Epi, bool PERMA, class Sched, int KP>
__device__ __forceinline__ void gemm_phase(LAS unsigned char* lds, const Gemm g, const Sched& S, const Epi& E) {
    int tid_ = threadIdx.x; asm volatile("" : "+v"(tid_));
    const int tid = tid_, wid = __builtin_amdgcn_readfirstlane(tid >> 6), lane = tid & 63, wr = wid >> 2, wc = wid & 3, fr = lane & 15, fq = lane >> 4;
    constexpr int K = KP;
    unsigned voffA[2], voffB[2];
#pragma unroll
    for (int i = 0; i < 2; ++i) { int R, C; stage_rc(tid * 16 + i * 8192, R, C); const int Rb = Epi::PERM ? ((R & ~31) + perm32(R & 31)) : R;
        const int Ra = PERMA ? (8 * (16 * (R >> 6) + (R & 15)) + ((R >> 4) & 3)) : R;
        voffA[i] = (unsigned)(Ra * K + C) * 2u; voffB[i] = (unsigned)(Rb * K + C) * 2u; }
    const size_t kstep = (size_t)(BK * 2);
    const size_t hstepB = (size_t)HALF * K * 2;
    const size_t hstepA = PERMA ? (size_t)4 * K * 2 : hstepB;
    const size_t tstep = 2 * hstepB;
    const unsigned ldsw = (unsigned)wid * 1024u;
    const int aoff = lds_byte(wr * 64 + fr, fq * 8), boff = lds_byte(wc * 32 + fr, fq * 8);
#define PG8_SA(b, h) (((b) * 2 + (h)) * HTB)
#define PG8_SB(b, h) ((4 + (b) * 2 + (h)) * HTB)
#define PG8_STAGE(bufoff, gbase, voff) do { _Pragma("unroll") for (int _i = 0; _i < 2; ++_i) \
        __builtin_amdgcn_global_load_lds((const unsigned*)((const char*)(gbase) + (voff)[_i]), (LAS unsigned*)(lds + (bufoff) + ldsw + _i * 8192), 16, 0, 0); } while (0)
#define PG8_LDA(dst, b, h) do { _Pragma("unroll") for (int m = 0; m < 4; ++m) _Pragma("unroll") for (int k = 0; k < 2; ++k) dst[m][k] = *(const LAS bf16x8*)(lds + PG8_SA(b, h) + aoff + m * 2048 + k * 1024); } while (0)
#define PG8_LDB(dst, b, h) do { _Pragma("unroll") for (int n = 0; n < 2; ++n) _Pragma("unroll") for (int k = 0; k < 2; ++k) dst[n][k] = *(const LAS bf16x8*)(lds + PG8_SB(b, h) + boff + n * 2048 + k * 1024); } while (0)
#define PG8_MMA(ai, bj, At, Bt) do { __builtin_amdgcn_s_setprio(1); _Pragma("unroll") for (int m = 0; m < 4; ++m) _Pragma("unroll") for (int n = 0; n < 2; ++n) _Pragma("unroll") for (int k = 0; k < 2; ++k) \
        acc[ai][bj][m][n] = __builtin_amdgcn_mfma_f32_16x16x32_bf16(Bt[n][k], At[m][k], acc[ai][bj][m][n], 0, 0, 0); __builtin_amdgcn_s_setprio(0); } while (0)
#define PG8_WAIT_V(n) asm volatile("s_waitcnt vmcnt(" #n ")" ::: "memory")
#define PG8_WAIT_L(n) asm volatile("s_waitcnt lgkmcnt(" #n ")" ::: "memory")
#define PG8_BAR __builtin_amdgcn_s_barrier()
#define PG8_SCHED __builtin_amdgcn_sched_barrier(0)
    Unit cur, nxt; int ui = 0;
    if (!S.next(0, cur)) return;
    f32x4 acc[2][2][4][2];
#pragma unroll
    for (int a = 0; a < 2; ++a)
#pragma unroll
        for (int b = 0; b < 2; ++b)
#pragma unroll
            for (int m = 0; m < 4; ++m)
#pragma unroll
                for (int n = 0; n < 2; ++n) acc[a][b][m][n] = (f32x4){0.f, 0.f, 0.f, 0.f};
    bf16x8 At[4][2], B0[2][2], B1[2][2];
#define PG8_AOF(u) ((u).pm >= g.pm2 ? (const char*)g.A2 + (size_t)((u).pm - g.pm2) * tstep : (const char*)g.A + (size_t)(u).pm * tstep)
    const char* cA = PG8_AOF(cur) + (size_t)cur.koff * 2; const char* cB = (const char*)g.Bt + (size_t)cur.pn * tstep + (size_t)cur.koff * 2;
    PG8_STAGE(PG8_SB(0, 0), cB, voffB); PG8_STAGE(PG8_SB(0, 1), cB + hstepB, voffB); PG8_STAGE(PG8_SA(0, 0), cA, voffA); PG8_STAGE(PG8_SA(0, 1), cA + hstepA, voffA);
    if (wr == 1) PG8_BAR;
    PG8_WAIT_V(2); PG8_BAR;
    PG8_STAGE(PG8_SB(1, 0), cB + kstep, voffB); PG8_STAGE(PG8_SA(1, 0), cA + kstep, voffA); PG8_STAGE(PG8_SB(1, 1), cB + hstepB + kstep, voffB);
    PG8_WAIT_V(6); PG8_BAR;
    for (;;) {
        E.prefetch(lds + STAGE_BYTES, cur, ui & 1, wid, lane);
        const bool has_next = S.next(ui + 1, nxt);
        const char* nA = has_next ? PG8_AOF(nxt) + (size_t)nxt.koff * 2 : cA; const char* nB = has_next ? (const char*)g.Bt + (size_t)nxt.pn * tstep + (size_t)nxt.koff * 2 : cB;
        const int nt = cur.nt;
        for (int t = 0; t < nt; t += 2) {
            const bool last = (t == nt - 2);
            const char* a1 = cA + (size_t)(t + 1) * kstep;
            const char* a2 = last ? nA : cA + (size_t)(t + 2) * kstep; const char* b2 = last ? nB : cB + (size_t)(t + 2) * kstep;
            const char* a3 = a2 + kstep; const char* b3 = b2 + kstep;
            PG8_LDB(B0, 0, 0); PG8_LDB(B1, 0, 1); PG8_SCHED; PG8_LDA(At, 0, 0); PG8_STAGE(PG8_SA(1, 1), a1 + hstepA, voffA);
            PG8_WAIT_V(8); PG8_WAIT_L(0); PG8_BAR; PG8_MMA(0, 0, At, B0); PG8_MMA(0, 1, At, B1); PG8_BAR; PG8_SCHED;
            PG8_LDA(At, 0, 1); PG8_STAGE(PG8_SB(0, 0), b2, voffB); PG8_STAGE(PG8_SB(0, 1), b2 + hstepB, voffB); PG8_STAGE(PG8_SA(0, 0), a2, voffA);
            PG8_WAIT_V(8); PG8_WAIT_L(0); PG8_BAR; PG8_MMA(1, 0, At, B0); PG8_MMA(1, 1, At, B1); PG8_BAR; PG8_SCHED;
            PG8_LDB(B0, 1, 0); PG8_LDB(B1, 1, 1); PG8_SCHED; PG8_LDA(At, 1, 0); PG8_STAGE(PG8_SA(0, 1), a2 + hstepA, voffA);
            PG8_WAIT_V(8); PG8_WAIT_L(0); PG8_BAR; PG8_MMA(0, 0, At, B0); PG8_MMA(0, 1, At, B1); PG8_BAR; PG8_SCHED;
            PG8_LDA(At, 1, 1); PG8_STAGE(PG8_SB(1, 0), b3, voffB); PG8_STAGE(PG8_SB(1, 1), b3 + hstepB, voffB); PG8_STAGE(PG8_SA(1, 0), a3, voffA);
            PG8_WAIT_V(8); PG8_WAIT_L(0); PG8_BAR; PG8_MMA(1, 0, At, B0); PG8_MMA(1, 1, At, B1); PG8_BAR; PG8_SCHED;
        }
        if (wr == 0) PG8_BAR;
        bool run_epi = true;
        if (cur.nsplit > 1) {
            typedef unsigned long long u64;
            u64* myp = (u64*)S.part + ((size_t)(cur.tile * cur.nsplit + cur.ks) * 8 + wid) * 4096 + lane;
#pragma unroll
            for (int a = 0; a < 2; ++a)
#pragma unroll
                for (int b = 0; b < 2; ++b)
#pragma unroll
                    for (int m = 0; m < 4; ++m)
#pragma unroll
                        for (int n = 0; n < 2; ++n) { const f32x4 v = acc[a][b][m][n]; const int r = ((a * 2 + b) * 4 + m) * 2 + n;
                            __hip_atomic_store(myp + (2 * r) * 64, ((u64)__float_as_uint(v[1]) << 32) | __float_as_uint(v[0]), __ATOMIC_RELAXED, __HIP_MEMORY_SCOPE_AGENT);
                            __hip_atomic_store(myp + (2 * r + 1) * 64, ((u64)__float_as_uint(v[3]) << 32) | __float_as_uint(v[2]), __ATOMIC_RELAXED, __HIP_MEMORY_SCOPE_AGENT); }
            asm volatile("s_waitcnt vmcnt(0)" ::: "memory");
            unsigned old = 0;
            if (lane == 0) old = __hip_atomic_fetch_add(S.cnt + cur.tile * 8 + wid, 1u, __ATOMIC_RELAXED, __HIP_MEMORY_SCOPE_AGENT);
            old = __builtin_amdgcn_readfirstlane(old);
            if (old == (unsigned)(cur.nsplit - 1)) {
#pragma unroll
                for (int a = 0; a < 2; ++a)
#pragma unroll
                    for (int b = 0; b < 2; ++b)
#pragma unroll
                        for (int m = 0; m < 4; ++m)
#pragma unroll
                            for (int n = 0; n < 2; ++n) acc[a][b][m][n] = (f32x4){0.f, 0.f, 0.f, 0.f};
                for (int k2 = 0; k2 < cur.nsplit; ++k2) {
                    u64* pp = (u64*)S.part + ((size_t)(cur.tile * cur.nsplit + k2) * 8 + wid) * 4096 + lane;
#pragma unroll
                    for (int a = 0; a < 2; ++a)
#pragma unroll
                        for (int b = 0; b < 2; ++b)
#pragma unroll
                            for (int m = 0; m < 4; ++m)
#pragma unroll
                                for (int n = 0; n < 2; ++n) { const int r = ((a * 2 + b) * 4 + m) * 2 + n;
                                    typedef float f32x2 __attribute__((ext_vector_type(2)));
                                    const f32x2 lo = *(const f32x2*)(pp + (2 * r) * 64), hi2 = *(const f32x2*)(pp + (2 * r + 1) * 64);
                                    acc[a][b][m][n] += (f32x4){lo[0], lo[1], hi2[0], hi2[1]}; }
                }
            } else run_epi = false;
        }
        if (run_epi) E(acc, cur, wr, wc, fr, fq, lds + STAGE_BYTES, ui & 1);
        if (!has_next) break;
#pragma unroll
        for (int a = 0; a < 2; ++a)
#pragma unroll
            for (int b = 0; b < 2; ++b)
#pragma unroll
                for (int m = 0; m < 4; ++m)
#pragma unroll
                    for (int n = 0; n < 2; ++n) acc[a][b][m][n] = (f32x4){0.f, 0.f, 0.f, 0.f};
        cur = nxt; cA = nA; cB = nB; ++ui;
        if (wr == 1) PG8_BAR;
    }
    PG8_WAIT_V(0);
    PG8_BAR;
#undef PG8_AOF
#undef PG8_SA
#undef PG8_SB
#undef PG8_STAGE
#undef PG8_LDA
#undef PG8_LDB
#undef PG8_MMA
#undef PG8_WAIT_V
#undef PG8_WAIT_L
#undef PG8_BAR
#undef PG8_SCHED
}

struct EpiZ {
    __device__ __forceinline__ void prefetch(LAS unsigned char*, const Unit&, int, int, int) const {}
    static constexpr bool PERM = true;
    unsigned char* ws; float* out; const float* const* gains;
    __device__ __forceinline__ void operator()(const f32x4 (&acc)[2][2][4][2], const Unit& u, int wr, int wc, int fr, int fq, LAS unsigned char* xl, int par) const {
        const bool mem = u.pm >= 66;
        const int pn = mem ? u.pn - 18 : u.pn;
        int kind; const float* gp;
        int gi;
        if (mem) { kind = pn < 2 ? 1 : 2; gi = 4; }
        else if (pn < 4) { kind = 0; gi = 0; } else if (pn < 8) { kind = 1; gi = 1; } else if (pn == 12 || pn == 13) { kind = 0; gi = 3; } else { kind = 2; gi = 0; }
        gp = gains[gi];
        const int dcol = wc * 32 + 8 * fq;
        float rs[2][4][2];
#pragma unroll
        for (int ai = 0; ai < 2; ++ai)
#pragma unroll
            for (int m = 0; m < 4; ++m) { rs[ai][m][0] = 1.f; rs[ai][m][1] = 1.f; }
        if (kind != 2) {
            LAS float* P = (LAS float*)xl;
#pragma unroll
            for (int ai = 0; ai < 2; ++ai)
#pragma unroll
                for (int m = 0; m < 4; ++m)
#pragma unroll
                    for (int bj = 0; bj < 2; ++bj) { const f32x4 v0 = acc[ai][bj][m][0], v1 = acc[ai][bj][m][1];
                        float ss = (v0[0] * v0[0] + v0[1] * v0[1]) + (v0[2] * v0[2] + v0[3] * v0[3]) + (v1[0] * v1[0] + v1[1] * v1[1]) + (v1[2] * v1[2] + v1[3] * v1[3]);
                        ss += __shfl_xor(ss, 16); ss += __shfl_xor(ss, 32);
                        if (fq == 0) P[((ai * HALF + wr * 64 + m * 16 + fr) * 2 + bj) * 4 + wc] = ss; }
            asm volatile("s_waitcnt lgkmcnt(0)" ::: "memory"); __builtin_amdgcn_s_barrier(); asm volatile("" ::: "memory");
#pragma unroll
            for (int ai = 0; ai < 2; ++ai)
#pragma unroll
                for (int m = 0; m < 4; ++m)
#pragma unroll
                    for (int bj = 0; bj < 2; ++bj) { const f32x4 q = *(const LAS f32x4*)(P + ((ai * HALF + wr * 64 + m * 16 + fr) * 2 + bj) * 4);
                        rs[ai][m][bj] = rsqrtf(((q[0] + q[1]) + (q[2] + q[3])) * (1.f / 128.f) + EPS); }
        }
        float g8[8];
        { const f32x4 ga = *(const f32x4*)(gp + dcol), gb = *(const f32x4*)(gp + dcol + 4); const float sc = kind == 0 ? QSCALE : 1.f;
#pragma unroll
          for (int e = 0; e < 4; ++e) { g8[e] = kind == 2 ? 1.f : ga[e] * sc; g8[4 + e] = kind == 2 ? 1.f : gb[e] * sc; } }
#pragma unroll
        for (int ai = 0; ai < 2; ++ai)
#pragma unroll
            for (int m = 0; m < 4; ++m) {
                const int rl = ai * HALF + wr * 64 + m * 16 + fr;
#pragma unroll
                for (int bj = 0; bj < 2; ++bj) {
                    const float r = rs[ai][m][bj]; float x[8];
#pragma unroll
                    for (int e = 0; e < 4; ++e) { x[e] = acc[ai][bj][m][0][e] * r * g8[e]; x[4 + e] = acc[ai][bj][m][1][e] * r * g8[4 + e]; }
                    u32x4 w; w.x = cvt_pk(x[0], x[1]); w.y = cvt_pk(x[2], x[3]); w.z = cvt_pk(x[4], x[5]); w.w = cvt_pk(x[6], x[7]);
                    if (mem) {
                        const int mr = (u.pm - 66) * BM + rl, hh = pn * 2 + bj, hd = hh & 3;
                        *(u32x4*)((bf16_t*)(ws + (hh < 4 ? WS_MKP : WS_MVP)) + (size_t)mr * 512 + hd * 128 + dcol) = w;
                        float* op = out + (hh < 4 ? O_MKP : O_MVP) + (size_t)mr * 512 + hd * 128 + dcol;
                        *(f32x4*)op = (f32x4){x[0], x[1], x[2], x[3]}; *(f32x4*)(op + 4) = (f32x4){x[4], x[5], x[6], x[7]};
                    } else {
                        const int row = u.pm * BM + rl, hh = pn * 2 + bj, col = hh * 128 + dcol;
                        *(u32x4*)((bf16_t*)(ws + WS_Z) + (size_t)row * DIN + col) = w;
                        const bool smp = row >= MP; const int t = smp ? ((row - MP) & 31) : (row & 4095); const int sq = smp ? ((row - MP) >> 5) : (row >> 12);
                        if (hh >= 8 && hh < 24) {
                            const bool isk = hh < 16; const int hd = hh & 7;
                            if (smp) *(u32x4*)((bf16_t*)(ws + (isk ? WS_KS : WS_VS)) + ((size_t)sq * 544 + 512 + t) * 1024 + hd * 128 + dcol) = w;
                            if (smp || t >= 3584) {
                                float* op = smp ? out + (isk ? O_AKS : O_AVS) + (size_t)(row - MP) * 1024 : out + (isk ? O_AKP : O_AVP) + (size_t)(sq * 512 + t - 3584) * 1024;
                                op += hd * 128 + dcol;
                                *(f32x4*)op = (f32x4){x[0], x[1], x[2], x[3]}; *(f32x4*)(op + 4) = (f32x4){x[4], x[5], x[6], x[7]};
                            }
                        } else if (hh >= 28 && hh < 32) {
                            const int tl3 = smp ? t - 29 : t - 4093;
                            if (tl3 >= 0) { float* op = out + (smp ? O_BCS : O_BCP) + (size_t)(sq * 3 + tl3) * 512 + (col - 3584);
                                *(f32x4*)op = (f32x4){x[0], x[1], x[2], x[3]}; *(f32x4*)(op + 4) = (f32x4){x[4], x[5], x[6], x[7]}; }
                        }
                    }
                }
            }
    }
};
struct EpiOut {
    __device__ __forceinline__ void prefetch(LAS unsigned char*, const Unit&, int, int, int) const {}
    static constexpr bool PERM = false;
    const float* xp; const float* xs; float* out; bf16_t* XG; const float* gffn; float* ssq;
    __device__ __forceinline__ void operator()(const f32x4 (&acc)[2][2][4][2], const Unit& u, int wr, int wc, int fr, int fq, LAS unsigned char* xl, int par) const {
        const int row0 = u.pm * BM + wr * 64 + fr, col0 = u.pn * BM + wc * 32 + 4 * fq;
#pragma unroll
        for (int ai = 0; ai < 2; ++ai)
#pragma unroll
            for (int m = 0; m < 4; ++m) { const int row = row0 + ai * HALF + m * 16;
                const float* xrow = row < MP ? xp + (size_t)row * DM : xs + (size_t)(row - MP) * DM; float s = 0.f;
#pragma unroll
                for (int bj = 0; bj < 2; ++bj)
#pragma unroll
                    for (int n = 0; n < 2; ++n) { const int col = col0 + bj * HALF + n * 16;
                        const f32x4 x1 = *(const f32x4*)(xrow + col) + acc[ai][bj][m][n];
                        *(f32x4*)(out + (size_t)row * DM + col) = x1;
                        s += (x1[0] * x1[0] + x1[1] * x1[1]) + (x1[2] * x1[2] + x1[3] * x1[3]);
                        const f32x4 gv = *(const f32x4*)(gffn + col);
                        u32x2 w; w.x = cvt_pk(x1[0] * gv[0], x1[1] * gv[1]); w.y = cvt_pk(x1[2] * gv[2], x1[3] * gv[3]);
                        *(u32x2*)(XG + (size_t)row * DM + col) = w; }
                s += __shfl_xor(s, 16); s += __shfl_xor(s, 32);
                if (fq == 0) atomicAdd(ssq + row, s); }
    }
};
struct EpiDown {
    __device__ __forceinline__ void prefetch(LAS unsigned char*, const Unit&, int, int, int) const {}
    static constexpr bool PERM = false;
    float* out;
    __device__ __forceinline__ void operator()(const f32x4 (&acc)[2][2][4][2], const Unit& u, int wr, int wc, int fr, int fq, LAS unsigned char* xl, int par) const {
        const int row0 = u.pm * BM + wr * 64 + fr, col0 = u.pn * BM + wc * 32 + 4 * fq;
#pragma unroll
        for (int ai = 0; ai < 2; ++ai)
#pragma unroll
            for (int m = 0; m < 4; ++m) { float* orow = out + (size_t)(row0 + ai * HALF + m * 16) * DM + col0;
#pragma unroll
                for (int bj = 0; bj < 2; ++bj)
#pragma unroll
                    for (int n = 0; n < 2; ++n) { f32x4* p = (f32x4*)(orow + bj * HALF + n * 16); *p = *p + acc[ai][bj][m][n]; } }
    }
};
struct EpiUp {
    __device__ __forceinline__ void prefetch(LAS unsigned char* xl, const Unit& u, int par, int wid, int lane) const {
        if (wid < 5) {
            const float* src;
            if (wid < 4) src = (wid < 3 ? cfw + wid * DUP : cfb) + (lane < 32 ? 0 : DFF - 128) + u.pn * 128 + 4 * lane;
            else src = ssq + u.pm * BM + 4 * lane;
            __builtin_amdgcn_global_load_lds((const unsigned*)src, (LAS unsigned*)(xl + par * 5120 + wid * 1024), 16, 0, 0);
        }
    }
    static constexpr bool PERM = true;
    const float* ssq; const float* cfw; const float* cfb; const float* cache_f; float* out; bf16_t* H; float* UB; bf16_t* HS;
    __device__ __forceinline__ void operator()(const f32x4 (&acc)[2][2][4][2], const Unit& u, int wr, int wc, int fr, int fq, LAS unsigned char* xl, int par) const {
        const int rho = 16 * wr + fr, tok0 = u.pm * BM + 8 * rho;
        const bool sample = u.pm >= 64;
        const LAS float* xp = (const LAS float*)(xl + par * 5120);
        float rs[8];
        { const f32x4 q0 = *(const LAS f32x4*)(xp + 1024 + 8 * rho), q1 = *(const LAS f32x4*)(xp + 1024 + 8 * rho + 4);
#pragma unroll
          for (int j = 0; j < 4; ++j) { rs[j] = rsqrtf(q0[j] * (1.0f / DM) + EPS); rs[4 + j] = rsqrtf(q1[j] * (1.0f / DM) + EPS); } }
        const int bnd = 2 * u.pm + wr;
        const bool from_cache = sample && ((rho & 3) == 0);
        const bool seq_start = !sample && fr == 0 && ((bnd & 31) == 0);
        const bool incomplete = !sample && fr == 0 && ((bnd & 31) != 0);
        const bool tail_writer = !sample && fr == 15 && (((bnd + 1) & 31) != 0);
        const bool fc_writer = sample ? ((rho & 3) == 3) : (rho == 31 && (u.pm & 15) == 15);
        const int sidx = sample ? (tok0 - MP) >> 5 : (tok0 >> 12);
        float* fc_out = out + (sample ? O_FCS : O_FCP) + (size_t)sidx * 2 * DUP;
#pragma unroll
        for (int n = 0; n < 2; ++n) {
            const int kap = u.pn * 128 + wc * 32 + 8 * fq + 4 * n;
            f32x4 y[2][8];
#pragma unroll
            for (int bj = 0; bj < 2; ++bj) {
                const int col = bj * DFF + kap;
                const int kl = bj * 128 + wc * 32 + 8 * fq + 4 * n;
                const f32x4 w0 = *(const LAS f32x4*)(xp + kl), w1 = *(const LAS f32x4*)(xp + 256 + kl), w2 = *(const LAS f32x4*)(xp + 512 + kl), cb = *(const LAS f32x4*)(xp + 768 + kl);
                f32x4 U[8];
#pragma unroll
                for (int j = 0; j < 8; ++j) U[j] = acc[j >> 2][bj][j & 3][n] * rs[j];
                f32x4 p1, p2;
#pragma unroll
                for (int e = 0; e < 4; ++e) { p1[e] = __shfl_up(U[7][e], 1, 16); p2[e] = __shfl_up(U[6][e], 1, 16); }
                if (from_cache) { p2 = *(const f32x4*)(cache_f + (size_t)(sidx * 2 + 0) * DUP + col); p1 = *(const f32x4*)(cache_f + (size_t)(sidx * 2 + 1) * DUP + col); }
                if (seq_start || incomplete) { p1 = (f32x4){0.f, 0.f, 0.f, 0.f}; p2 = p1; }
                if (incomplete) { *(f32x4*)(UB + ((size_t)(bnd * 4 + 2) * 2 + bj) * DFF + kap) = U[0]; *(f32x4*)(UB + ((size_t)(bnd * 4 + 3) * 2 + bj) * DFF + kap) = U[1]; }
                if (tail_writer) { *(f32x4*)(UB + ((size_t)((bnd + 1) * 4 + 0) * 2 + bj) * DFF + kap) = U[6]; *(f32x4*)(UB + ((size_t)((bnd + 1) * 4 + 1) * 2 + bj) * DFF + kap) = U[7]; }
                if (fc_writer) { *(f32x4*)(fc_out + col) = U[6]; *(f32x4*)(fc_out + DUP + col) = U[7]; }
                y[bj][0] = cb + w0 * p2 + w1 * p1 + w2 * U[0];
                y[bj][1] = cb + w0 * p1 + w1 * U[0] + w2 * U[1];
#pragma unroll
                for (int j = 2; j < 8; ++j) y[bj][j] = cb + w0 * U[j - 2] + w1 * U[j - 1] + w2 * U[j];
            }
#pragma unroll
            for (int j = 0; j < 8; ++j) {
                if (j < 2 && incomplete) continue;
                const f32x4 v = y[0][j], gt = y[1][j];
                u32x2 w; w.x = cvt_pk(gelu_tanh(gt[0]) * v[0], gelu_tanh(gt[1]) * v[1]); w.y = cvt_pk(gelu_tanh(gt[2]) * v[2], gelu_tanh(gt[3]) * v[3]);
                *(u32x2*)((sample ? HS + (size_t)(tok0 - MP + j) * DFF : H + (size_t)(tok0 + j) * DFF) + kap) = w;
            }
        }
    }
};
}

struct Args { const float* in[32]; float* out; unsigned char* ws; };
constexpr int LDS_BYTES = 147456;
constexpr int ATT_REGION = 16896, ATT_TAB = 8 * ATT_REGION, ATT_LSM = ATT_TAB + 3328;
constexpr int LRU_XCT = 0, LRU_AGG = 65536, LRU_CW = 81920, LRU_W = 83968;
constexpr int MISC_OFF = 147328;


#define XB_TMO      128
#define XB_XCNT(j)  (256  + 64 * (j))
#define XB_XSUB(j)  (1280 + 64 * (j))
#define XB_XGEN(j)  (2304 + 64 * (j))
#define XB_TOP      3328
#define XB_TOPGEN   3392
#define XCD_BAR_WORDS 3456
#define XB_SPIN_CAP (1u << 18)
__device__ __forceinline__ unsigned xb_ld(unsigned* p)              { return __hip_atomic_load(p, __ATOMIC_RELAXED, __HIP_MEMORY_SCOPE_AGENT); }
__device__ __forceinline__ unsigned xb_add(unsigned* p, unsigned v) { return __hip_atomic_fetch_add(p, v, __ATOMIC_RELAXED, __HIP_MEMORY_SCOPE_AGENT); }
__device__ __forceinline__ unsigned xb_xcc_id() { return (unsigned)__builtin_amdgcn_s_getreg((3 << 11) | 20) & 0xFu; }
#define XB_SPIN(cond, bar) do { unsigned _sp = 0; while (cond) { __builtin_amdgcn_s_sleep(1); \
    if ((++_sp & 255u) == 0u) { if (xb_ld(&(bar)[XB_TMO])) break; if (_sp > XB_SPIN_CAP) { atomicAdd(&(bar)[XB_TMO], 1u); break; } } } } while (0)
struct XcdBarrier { unsigned* bar; unsigned x; volatile LAS unsigned* st; };
__device__ __forceinline__ XcdBarrier xcd_barrier_post(unsigned* bar, volatile LAS unsigned* st) {
    XcdBarrier b; b.bar = bar; b.x = xb_xcc_id(); b.st = st;
    if (threadIdx.x == 0) (void)xb_add(&bar[XB_XCNT(b.x)], 1u);
    return b;
}
__device__ __forceinline__ void xcd_barrier_complete(unsigned* bar, unsigned x, unsigned& nloc, unsigned& nx) {
    const unsigned G = gridDim.x * gridDim.y * gridDim.z;
    unsigned sum, cnt, mine, sp = 0u;
    for (;;) {
        sum = 0u; cnt = 0u; mine = 0u;
#pragma unroll
        for (unsigned j = 0; j < 16; ++j) { const unsigned c = xb_ld(&bar[XB_XCNT(j)]); sum += c; cnt += (c > 0u) ? 1u : 0u; mine = (j == x) ? c : mine; }
        if (sum == G) break;
        __builtin_amdgcn_s_sleep(1);
        if ((++sp & 255u) == 0u) { if (xb_ld(&bar[XB_TMO])) break; if (sp > XB_SPIN_CAP) { atomicAdd(&bar[XB_TMO], 1u); break; } }
    }
    nloc = mine > 0u ? mine : 1u; nx = cnt > 0u ? cnt : 1u;
}
__device__ __forceinline__ void xcd_barrier(const XcdBarrier& b) {
    asm volatile("s_waitcnt vmcnt(0)" ::: "memory");
    __syncthreads();
    if (threadIdx.x == 0) {
        unsigned* bar = b.bar;
        __builtin_amdgcn_s_waitcnt(0);
        unsigned nloc = b.st[0], nx = b.st[1];
        if (nloc == 0u) { xcd_barrier_complete(bar, b.x, nloc, nx); b.st[0] = nloc; b.st[1] = nx; }
        const unsigned old = xb_add(&bar[XB_XSUB(b.x)], 1u);
        const unsigned gen = old / nloc;
        if (old + 1u == (gen + 1u) * nloc) {
            __builtin_amdgcn_fence(__ATOMIC_RELEASE, "agent");
            asm volatile("s_waitcnt vmcnt(0)" ::: "memory");
            const unsigned og = xb_add(&bar[XB_TOP], 1u);
            const unsigned tg = og / nx;
            if (og + 1u == (tg + 1u) * nx) xb_add(&bar[XB_TOPGEN], 1u);
            else XB_SPIN(xb_ld(&bar[XB_TOPGEN]) == tg, bar);
            __builtin_amdgcn_fence(__ATOMIC_ACQUIRE, "agent");
            xb_add(&bar[XB_XGEN(b.x)], 1u);
            asm volatile("s_waitcnt vmcnt(0)" ::: "memory");
        } else {
            XB_SPIN(xb_ld(&bar[XB_XGEN(b.x)]) == gen, bar);
            __builtin_amdgcn_fence(__ATOMIC_ACQUIRE, "agent");
            asm volatile("s_waitcnt vmcnt(0)" ::: "memory");
        }
    }
    __syncthreads();
}

struct P0Tile { const float* W; bf16_t* WT; int K, N, mode, row_off, tile; };
__device__ __forceinline__ void p0_tile_load(const P0Tile& t, int tid, f32x4 (&v)[4]) {
    const int nblk = t.N / 64, kb = t.tile / nblk, nb = t.tile % nblk, k0 = 128 * kb, n0 = 64 * nb;
    const int n4 = tid & 15, kr = tid >> 4;
#pragma unroll
    for (int i = 0; i < 4; ++i) v[i] = *(const f32x4*)(t.W + (size_t)(k0 + kr + 32 * i) * t.N + n0 + 4 * n4);
}
__device__ __forceinline__ void p0_tile_finish(const P0Tile& t, int tid, const f32x4 (&v)[4], LAS float* scr) {
    const int nblk = t.N / 64, kb = t.tile / nblk, nb = t.tile % nblk, k0 = 128 * kb, n0 = 64 * nb;
    const int n4 = tid & 15, kr = tid >> 4;
    __syncthreads();
#pragma unroll
    for (int i = 0; i < 4; ++i) { LAS float* d = scr + (kr + 32 * i) * 65 + 4 * n4; d[0] = v[i][0]; d[1] = v[i][1]; d[2] = v[i][2]; d[3] = v[i][3]; }
    __syncthreads();
    int rbase;
    if (t.mode == 0) rbase = t.row_off + n0;
    else rbase = (n0 < DFF) ? (256 * (n0 >> 7) + (n0 & 127)) : (256 * ((n0 - DFF) >> 7) + 128 + ((n0 - DFF) & 127));
    const int n = tid >> 3, c = tid & 7;
    const LAS float* sp = scr + (16 * c) * 65 + n;
    u32x4 o0, o1;
    o0.x = cvt_pk(sp[0 * 65], sp[1 * 65]); o0.y = cvt_pk(sp[2 * 65], sp[3 * 65]); o0.z = cvt_pk(sp[4 * 65], sp[5 * 65]); o0.w = cvt_pk(sp[6 * 65], sp[7 * 65]);
    o1.x = cvt_pk(sp[8 * 65], sp[9 * 65]); o1.y = cvt_pk(sp[10 * 65], sp[11 * 65]); o1.z = cvt_pk(sp[12 * 65], sp[13 * 65]); o1.w = cvt_pk(sp[14 * 65], sp[15 * 65]);
    bf16_t* dp = t.WT + (size_t)(rbase + n) * t.K + k0 + 16 * c;
    *(u32x4*)dp = o0; *(u32x4*)(dp + 8) = o1;
}
__device__ __forceinline__ void rms_row_to_bf16(const float* xrow, const float* g, bf16_t* orow, int lane) {
    const f32x4* xr = (const f32x4*)xrow + lane; const f32x4* gr = (const f32x4*)g + lane;
    f32x4 v[8]; float s = 0.f;
#pragma unroll
    for (int j = 0; j < 8; ++j) { v[j] = xr[64 * j]; s += (v[j][0] * v[j][0] + v[j][1] * v[j][1]) + (v[j][2] * v[j][2] + v[j][3] * v[j][3]); }
    const float rstd = rsqrtf(wave_sum(s) * (1.f / DM) + EPS);
    u32x2* o8 = (u32x2*)orow + lane;
#pragma unroll
    for (int j = 0; j < 8; ++j) { const f32x4 gg = gr[64 * j]; u32x2 w; w.x = cvt_pk(v[j][0] * rstd * gg[0], v[j][1] * rstd * gg[1]); w.y = cvt_pk(v[j][2] * rstd * gg[2], v[j][3] * rstd * gg[3]); o8[64 * j] = w; }
}
__device__ __forceinline__ u32x4 cvt8(const float* p) { const f32x4 a = *(const f32x4*)p, b = *(const f32x4*)(p + 4); u32x4 o; o.x = cvt_pk(a[0], a[1]); o.y = cvt_pk(a[2], a[3]); o.z = cvt_pk(b[0], b[1]); o.w = cvt_pk(b[2], b[3]); return o; }

struct AttnArgs { const bf16_t* Q; int qpitch; int nq; const bf16_t* K; const bf16_t* V; int kvpitch; int ntiles; int j0; const float* table; bf16_t* O; int opitch; };
typedef short v4i16_t __attribute__((ext_vector_type(4)));
__device__ __forceinline__ s16x4 vtr(LAS unsigned char* p) { return __builtin_bit_cast(s16x4, __builtin_amdgcn_ds_read_tr16_b64_v4i16((LAS v4i16_t*)p)); }

__device__ __forceinline__ void attn_dma_tile(const bf16_t* src, int kvpitch, int key0, LAS unsigned char* dst, int lane) {
#pragma unroll
    for (int i = 0; i < 8; ++i) {
        const int row = 4 * i + (lane >> 4), ch = (lane & 15) ^ ((((lane >> 4) & 3) << 2) | (i & 3));
        __builtin_amdgcn_global_load_lds((const unsigned*)(src + (size_t)(key0 + row) * kvpitch + ch * 8), (LAS unsigned*)(dst + i * 1024), 16, 0, 0);
    }
}
__device__ __forceinline__ void attn_unit(LAS unsigned char* lds, const AttnArgs a) {
    int tid_ = threadIdx.x; asm volatile("" : "+v"(tid_));
    const int tid = tid_, lane = tid & 63, r32 = lane & 31, hi = lane >> 5;
    const int wave = __builtin_amdgcn_readfirstlane(tid >> 6);
    const int qh = wave & 1, g = wave >> 1;
    LAS float* tab = (LAS float*)(lds + ATT_TAB);
    LAS float* lsm = (LAS float*)(lds + ATT_LSM);
    LAS unsigned char* myr = lds + wave * ATT_REGION;
    const int nit = (a.ntiles + 3) >> 2;
    const bf16_t* dsrc = qh ? a.V : a.K;
    __syncthreads();
    if (a.table) { tab[tid] = a.table[tid] * LOG2E; if (tid < 320) tab[512 + tid] = a.table[512] * LOG2E; }
    bf16x8 qf[8];
    { const bf16_t* qp = a.Q + (size_t)(qh * 32 + r32) * a.qpitch + hi * 8;
#pragma unroll
      for (int s = 0; s < 8; ++s) qf[s] = *(const bf16x8*)(qp + 16 * s); }
    if (g < a.ntiles) attn_dma_tile(dsrc, a.kvpitch, g * 32, lds + g * 16384 + qh * 8192, lane);
    asm volatile("s_waitcnt vmcnt(0)" ::: "memory");
    __syncthreads();
    f32x16 o[4];
#pragma unroll
    for (int c = 0; c < 4; ++c)
#pragma unroll
        for (int r = 0; r < 16; ++r) o[c][r] = 0.f;
    float lsum = 0.f;
    const int iq = qh * 32 + r32;
    const int q4 = (lane & 15) >> 2, p4 = lane & 3, blk = (lane >> 4) & 1;
    for (int it = 0; it < nit; ++it) {
        const int kt = 4 * it + g;
        if ((kt + 4) < a.ntiles) attn_dma_tile(dsrc, a.kvpitch, (kt + 4) * 32, lds + ((it + 1) & 1) * 65536 + g * 16384 + qh * 8192, lane);
        if (kt < a.ntiles) {
            const int key0 = kt * 32;
            LAS unsigned char* kb = lds + (it & 1) * 65536 + g * 16384;
            LAS unsigned char* vb = kb + 8192;
            f32x16 sacc;
#pragma unroll
            for (int r = 0; r < 16; ++r) sacc[r] = 0.f;
            __builtin_amdgcn_s_setprio(1);
#pragma unroll
            for (int s = 0; s < 8; ++s) { const bf16x8 kf = *(const LAS bf16x8*)(kb + off_b(r32, 2 * s + hi)); sacc = __builtin_amdgcn_mfma_f32_32x32x16_bf16(kf, qf[s], sacc, 0, 0, 0); }
            __builtin_amdgcn_s_setprio(0);
            float p[16];
            const bool far_tile = (qh * 32 + 512 - (a.j0 + key0 + 31)) >= 256;
            if (!a.table || far_tile) {
                const float cbias = a.table ? tab[512] : 0.f;
#pragma unroll
                for (int r = 0; r < 16; ++r) { p[r] = __builtin_amdgcn_exp2f(sacc[r] + cbias); lsum += p[r]; }
            } else {
                const LAS float* tp = tab + (iq + 768 - (a.j0 + key0 + 4 * hi) - 27);
#pragma unroll
                for (int r = 0; r < 16; ++r) { p[r] = __builtin_amdgcn_exp2f(sacc[r] + tp[27 - ((r & 3) + 8 * (r >> 2))]); lsum += p[r]; }
            }
            bf16x8 pf[2];
#pragma unroll
            for (int s2 = 0; s2 < 2; ++s2) { u32x4 w; w.x = cvt_pk(p[8 * s2 + 0], p[8 * s2 + 1]); w.y = cvt_pk(p[8 * s2 + 2], p[8 * s2 + 3]); w.z = cvt_pk(p[8 * s2 + 4], p[8 * s2 + 5]); w.w = cvt_pk(p[8 * s2 + 6], p[8 * s2 + 7]); pf[s2] = __builtin_bit_cast(bf16x8, w); }
            s16x4 vlo[8], vhi[8];
#pragma unroll
            for (int c = 0; c < 4; ++c)
#pragma unroll
                for (int s2 = 0; s2 < 2; ++s2) {
                    const unsigned r0a = 16 * s2 + 4 * hi, chn = 4 * c + 2 * blk + (p4 >> 1);
                    const unsigned a0 = (unsigned)(size_t)(vb + off_b(r0a + q4, chn) + 8 * (p4 & 1)), a1 = (unsigned)(size_t)(vb + off_b(r0a + 8 + q4, chn) + 8 * (p4 & 1));
                    asm volatile("ds_read_b64_tr_b16 %0, %1" : "=&v"(vlo[c * 2 + s2]) : "v"(a0) : "memory");
                    asm volatile("ds_read_b64_tr_b16 %0, %1" : "=&v"(vhi[c * 2 + s2]) : "v"(a1) : "memory");
                }
            asm volatile("s_waitcnt lgkmcnt(0)" ::: "memory");
            __builtin_amdgcn_sched_barrier(0);
#pragma unroll
            for (int c = 0; c < 4; ++c)
#pragma unroll
                for (int s2 = 0; s2 < 2; ++s2) {
                    const s16x4 lo = vlo[c * 2 + s2], h4 = vhi[c * 2 + s2];
                    const bf16x8 vf = (bf16x8){lo[0], lo[1], lo[2], lo[3], h4[0], h4[1], h4[2], h4[3]};
                    o[c] = __builtin_amdgcn_mfma_f32_32x32x16_bf16(vf, pf[s2], o[c], 0, 0, 0);
                }
        }
        asm volatile("s_waitcnt vmcnt(0) lgkmcnt(0)" ::: "memory");
        __syncthreads();
    }
    lsum += __shfl_xor(lsum, 32);
#pragma unroll
    for (int c = 0; c < 4; ++c)
#pragma unroll
        for (int r4 = 0; r4 < 4; ++r4) { const int d0 = 32 * c + 8 * r4 + 4 * hi;
            *(LAS f32x4*)(myr + (r32 * 132 + d0) * 4) = (f32x4){o[c][4 * r4 + 0], o[c][4 * r4 + 1], o[c][4 * r4 + 2], o[c][4 * r4 + 3]}; }
    if (hi == 0) lsm[wave * 32 + r32] = lsum;
    __syncthreads();
    { const int q = tid >> 3;
      if (q < a.nq) { const int qh2 = q >> 5, ql = q & 31, d0 = (tid & 7) * 16;
        f32x4 s0 = (f32x4){0.f, 0.f, 0.f, 0.f}, s1 = s0, s2 = s0, s3 = s0; float lt = 0.f;
#pragma unroll
        for (int gg = 0; gg < 4; ++gg) { const int w2 = gg * 2 + qh2; const LAS f32x4* rp = (const LAS f32x4*)(lds + w2 * ATT_REGION + (ql * 132 + d0) * 4);
            s0 += rp[0]; s1 += rp[1]; s2 += rp[2]; s3 += rp[3]; lt += lsm[w2 * 32 + ql]; }
        const float inv = 1.f / lt;
        u32x4 w0, w1;
        w0.x = cvt_pk(s0[0] * inv, s0[1] * inv); w0.y = cvt_pk(s0[2] * inv, s0[3] * inv); w0.z = cvt_pk(s1[0] * inv, s1[1] * inv); w0.w = cvt_pk(s1[2] * inv, s1[3] * inv);
        w1.x = cvt_pk(s2[0] * inv, s2[1] * inv); w1.y = cvt_pk(s2[2] * inv, s2[3] * inv); w1.z = cvt_pk(s3[0] * inv, s3[1] * inv); w1.w = cvt_pk(s3[2] * inv, s3[3] * inv);
        bf16_t* op = a.O + (size_t)q * a.opitch + d0;
        *(u32x4*)op = w0; *(u32x4*)(op + 8) = w1; } }
}

struct LruArgs { const bf16_t* Zrow0; int T; const float* conv_past; const float* h0; int n; int nb; bf16_t* MIXrow0; float* out_bh; };
__device__ __forceinline__ int tokmap(int rho) { return 16 * ((rho >> 2) & 1) + (rho & 3) + 4 * (rho >> 3); }

__device__ __forceinline__ void lru_unit(LAS unsigned char* lds, const LruArgs a, const Args& args) {
    typedef float f32x2 __attribute__((ext_vector_type(2)));
    int tid_ = threadIdx.x; asm volatile("" : "+v"(tid_));
    const int tid = tid_, lane = tid & 63, r32 = lane & 31, hi = lane >> 5;
    const int wave = __builtin_amdgcn_readfirstlane(tid >> 6);
    LAS float* xct = (LAS float*)(lds + LRU_XCT + wave * 8192);
    LAS f32x2* agg = (LAS f32x2*)(lds + LRU_AGG);
    LAS float* cwl = (LAS float*)(lds + LRU_CW);
    const int n = a.n;
    __syncthreads();
    if (tid < 256) cwl[tid] = args.in[19][(tid >> 6) * 512 + 64 * n + (tid & 63)];
    else if (tid < 320) cwl[tid] = args.in[20][64 * n + (tid - 256)];
    __syncthreads();
    LAS unsigned char* wl = lds + LRU_W;
#pragma unroll
    for (int ff = 0; ff < 2; ++ff) {
        const int f = wave + 8 * ff, gate = f >> 3, s = (f >> 1) & 3, nb = f & 1;
        const float* pw = (gate ? args.in[23] : args.in[21]) + (size_t)n * 4096 + (size_t)(16 * s + 8 * hi) * 64 + 32 * nb + r32;
        u32x4 uw; uw.x = cvt_pk(pw[0], pw[64]); uw.y = cvt_pk(pw[128], pw[192]); uw.z = cvt_pk(pw[256], pw[320]); uw.w = cvt_pk(pw[384], pw[448]);
        *(LAS u32x4*)(wl + (f * 64 + lane) * 16) = uw;
    }
    __syncthreads();
    const int nb = a.nb;
    const int chn = 64 * n + 32 * nb + r32;
    const float ba = args.in[22][chn], bi = args.in[24][chn], cl = -8.0f * log1pf(__expf(-args.in[25][chn]));
    float hsb = a.h0 ? a.h0[chn] : 0.f;
    const int nsb = (a.T + 255) >> 8;
    int par = 0;
    const int tl = tokmap(r32);
    u32x4 xw[4][4];
#define LRU_LOAD_X(SB) do { const int t0n_ = (SB) * 256 + 32 * wave; if (t0n_ < a.T) { const int tau_ = t0n_ + tl; \
        _Pragma("unroll") for (int s = 0; s < 4; ++s) _Pragma("unroll") for (int k = 0; k < 4; ++k) { const int tr = tau_ - 3 + k; const int ch0 = 16 * s + 8 * hi; \
            if (tr >= 0) xw[s][k] = *(const u32x4*)(a.Zrow0 + (size_t)tr * DIN + 3584 + 64 * n + ch0); \
            else if (a.conv_past) xw[s][k] = cvt8(a.conv_past + (size_t)(tr + 3) * 512 + 64 * n + ch0); \
            else xw[s][k] = (u32x4){0u, 0u, 0u, 0u}; } } } while (0)
    LRU_LOAD_X(0);
    for (int sb = 0; sb < nsb; ++sb) {
        const int t0 = sb * 256 + 32 * wave;
        const bool active = t0 < a.T;
        float hl[16], ac[16];
        bf16_t gw[16];
        if (active) {
#pragma unroll
            for (int r = 0; r < 16; ++r) gw[r] = a.Zrow0[(size_t)(t0 + 16 * hi + r) * DIN + 4096 + chn];
            bf16x8 af[4];
#pragma unroll
            for (int s = 0; s < 4; ++s) {
                const int ch0 = 16 * s + 8 * hi;
                float xc[8];
#pragma unroll
                for (int e = 0; e < 8; ++e) xc[e] = cwl[256 + ch0 + e];
#pragma unroll
                for (int k = 0; k < 4; ++k) {
                    const u32x4 w = xw[s][k];
                    const float xv[8] = {bf_lo(w.x), bf_hi(w.x), bf_lo(w.y), bf_hi(w.y), bf_lo(w.z), bf_hi(w.z), bf_lo(w.w), bf_hi(w.w)};
#pragma unroll
                    for (int e = 0; e < 8; ++e) xc[e] += cwl[k * 64 + ch0 + e] * xv[e];
                }
                *(LAS f32x4*)(xct + tl * 64 + ch0) = (f32x4){xc[0], xc[1], xc[2], xc[3]};
                *(LAS f32x4*)(xct + tl * 64 + ch0 + 4) = (f32x4){xc[4], xc[5], xc[6], xc[7]};
                u32x4 w; w.x = cvt_pk(xc[0], xc[1]); w.y = cvt_pk(xc[2], xc[3]); w.z = cvt_pk(xc[4], xc[5]); w.w = cvt_pk(xc[6], xc[7]);
                af[s] = __builtin_bit_cast(bf16x8, w);
            }
            LRU_LOAD_X(sb + 1);
            asm volatile("s_waitcnt lgkmcnt(0)" ::: "memory");
            f32x16 za, zi;
#pragma unroll
            for (int r = 0; r < 16; ++r) { za[r] = 0.f; zi[r] = 0.f; }
#pragma unroll
            for (int s = 0; s < 4; ++s) { const bf16x8 fa = *(const LAS bf16x8*)(wl + ((s * 2 + nb) * 64 + lane) * 16), fi = *(const LAS bf16x8*)(wl + ((8 + s * 2 + nb) * 64 + lane) * 16);
                za = __builtin_amdgcn_mfma_f32_32x32x16_bf16(af[s], fa, za, 0, 0, 0); zi = __builtin_amdgcn_mfma_f32_32x32x16_bf16(af[s], fi, zi, 0, 0, 0); }
            float hrun = 0.f, arun = 1.f;
#pragma unroll
            for (int r = 0; r < 16; ++r) {
                const float xcv = xct[(16 * hi + r) * 64 + 32 * nb + r32];
                const float rg = sigmoidf_(za[r] + ba), ig = sigmoidf_(zi[r] + bi);
                const float la = rg * cl;
                const float av = __builtin_amdgcn_exp2f(la * LOG2E);
                const float mult = __builtin_amdgcn_sqrtf(fmaxf(1.f - av * av, 0.f));
                const float uu = mult * (ig * xcv);
                hrun = av * hrun + uu; arun *= av;
                hl[r] = hrun; ac[r] = arun;
            }
            agg[(par * 16 + 2 * wave + hi) * 32 + r32] = (f32x2){arun, hrun};
        } else {
            agg[(par * 16 + 2 * wave + hi) * 32 + r32] = (f32x2){1.f, 0.f};
        }
        __syncthreads();
        float hin = 0.f;
        { float run = hsb;
#pragma unroll
          for (int sg = 0; sg < 16; ++sg) { const f32x2 ab = agg[(par * 16 + sg) * 32 + r32]; if (sg == 2 * wave + hi) hin = run; run = ab.x * run + ab.y; }
          hsb = run; }
        if (active) {
#pragma unroll
            for (int r = 0; r < 16; ++r) {
                const float h = hl[r] + ac[r] * hin;
                const int t = t0 + 16 * hi + r;
                const float ov = h * gelu_tanh(bf1(gw[r]));
                a.MIXrow0[(size_t)t * DM + 1536 + chn] = (bf16_t)(cvt_pk(ov, 0.f) & 0xffffu);
            }
        }
        par ^= 1;
    }
#undef LRU_LOAD_X
    if (wave == 0 && hi == 0) a.out_bh[chn] = hsb;
}

__global__ void __launch_bounds__(512) fwd_megakernel(Args args) {
    extern __shared__ __attribute__((aligned(16))) unsigned char lds_raw[];
    LAS unsigned char* lds = (LAS unsigned char*)lds_raw;
    cg::grid_group grid = cg::this_grid();
    const int tid = threadIdx.x, lane = tid & 63, wave = __builtin_amdgcn_readfirstlane(tid >> 6);
    const int G = gridDim.x, bx = blockIdx.x;
    unsigned char* ws = args.ws; float* out = args.out;
#define ctl ((unsigned*)(ws + WS_CTL))
#define ssq ((float*)(ws + WS_CTL) + CW_SSQ)
#define WIN ((bf16_t*)(ws + WS_WIN))
#define WOUT ((bf16_t*)(ws + WS_WOUT))
#define WUP ((bf16_t*)(ws + WS_WUP))
#define WDN ((bf16_t*)(ws + WS_WDN))
#define A1 ((bf16_t*)(ws + WS_A1))
#define XG ((bf16_t*)(ws + WS_A1))
#define Z ((bf16_t*)(ws + WS_Z))
#define H ((bf16_t*)(ws + WS_Z))
#define ZM ((bf16_t*)(ws + WS_ZM))
#define MIX ((bf16_t*)(ws + WS_MIX))
#define KS ((bf16_t*)(ws + WS_KS))
#define VS ((bf16_t*)(ws + WS_VS))
#define MKP ((bf16_t*)(ws + WS_MKP))
#define MVP ((bf16_t*)(ws + WS_MVP))
#define MKS ((bf16_t*)(ws + WS_MKS))
#define MVS ((bf16_t*)(ws + WS_MVS))
#define UB ((float*)(ws + WS_UB))
#define x_prompt (args.in[0])
#define x_sample (args.in[1])
    const int gw = bx * 8 + wave, NGW = G * 8;
    if (tid < 16) ((LAS unsigned*)(lds + MISC_OFF))[tid] = 0u;
    __syncthreads();
    const XcdBarrier xbar = xcd_barrier_post(ctl + CW_BAR, (volatile LAS unsigned*)(lds + MISC_OFF) + 8);

#ifndef REP0
#define REP0 1
#endif
    for (int rep0 = 0; rep0 < REP0; ++rep0) {
        if (rep0) grid.sync();
        LAS float* scr = (LAS float*)lds;
        constexpr int T_IN = 16 * 72, T_MEM = 16 * 16, T_OUT = 16 * 32, T_UP = 16 * 192, T_DN = 48 * 32;
        constexpr int NTILES = T_IN + T_MEM + T_OUT + T_UP + T_DN;
        auto decode = [&](int it) -> P0Tile {
            int r = it; P0Tile t;
            if (r < T_UP) { t = P0Tile{args.in[28], WUP, DM, DUP, 1, 0, r}; return t; } r -= T_UP;
            if (r < T_DN) { t = P0Tile{args.in[31], WDN, DFF, DM, 0, 0, r}; return t; } r -= T_DN;
            if (r < T_IN) { t = P0Tile{args.in[11], WIN, DM, DIN, 0, 0, r}; return t; } r -= T_IN;
            if (r < T_OUT) { t = P0Tile{args.in[26], WOUT, DM, DM, 0, 0, r}; return t; } r -= T_OUT;
            t = P0Tile{args.in[18], WIN, DM, 1024, 0, DIN, r}; return t;
        };
        if (bx < NTILES) {
            P0Tile cur = decode(bx); f32x4 v[4]; p0_tile_load(cur, tid, v);
            for (int it = bx; it < NTILES; it += G) {
                const bool more = it + G < NTILES;
                P0Tile nxt = cur; f32x4 vn[4];
                if (more) { nxt = decode(it + G); p0_tile_load(nxt, tid, vn); }
                p0_tile_finish(cur, tid, v, scr);
                if (more) { cur = nxt;
#pragma unroll
                    for (int i = 0; i < 4; ++i) v[i] = vn[i]; }
            }
        }
        for (int m = gw; m < MA1; m += NGW) {
            const float* xr; const float* g;
            if (m < MP) { xr = x_prompt + (size_t)m * DM; g = args.in[10]; }
            else if (m < MT) { xr = x_sample + (size_t)(m - MP) * DM; g = args.in[10]; }
            else { xr = args.in[9] + (size_t)(m - MT) * DM; g = args.in[17]; }
            rms_row_to_bf16(xr, g, A1 + (size_t)m * DM, lane);
        }
    }
    if (args.ws == nullptr) grid.sync();
    xcd_barrier(xbar);

    {
        pg8::Gemm g{A1, WIN, nullptr, 1 << 20}; typedef pg8::SchedT<66, 18, 32, 16, 66, 18, 4, 0, 0, 1> S1; S1 S{G, bx, nullptr, nullptr};
        pg8::EpiZ E{ws, out, &args.in[12]};
        pg8::gemm_phase<pg8::EpiZ, false, S1, DM>(lds, g, S, E);
        {
            LAS unsigned* misc = (LAS unsigned*)(lds + MISC_OFF);
            constexpr int C_AK = 16 * 512 * 1024 / 8, C_MK = 16 * 256 * 512 / 8, C_TOT = 2 * C_AK + 2 * C_MK, NGRP = C_TOT / 2048;
            for (;;) {
                __syncthreads();
                if (tid == 0) misc[0] = atomicAdd(ctl + CW_QCONV, 1u);
                __syncthreads();
                const int grp = (int)misc[0];
                if (grp >= NGRP) break;
                const float* src[4]; bf16_t* dst[4]; f32x4 va[4], vb[4];
#pragma unroll
                for (int u = 0; u < 4; ++u) {
                    int r = grp * 2048 + u * 512 + tid;
                    if (r < 2 * C_AK) { const int which = r >= C_AK; if (which) r -= C_AK;
                        const size_t e = (size_t)r * 8; const int sq = (int)(e >> 19), rem = (int)(e & 524287);
                        src[u] = (which ? args.in[3] : args.in[2]) + e; dst[u] = (which ? VS : KS) + (size_t)sq * 544 * 1024 + rem; }
                    else { r -= 2 * C_AK; const int which = r >= C_MK; if (which) r -= C_MK; const size_t e = (size_t)r * 8;
                        src[u] = (which ? args.in[5] : args.in[4]) + e; dst[u] = (which ? MVS : MKS) + e; }
                    va[u] = *(const f32x4*)src[u]; vb[u] = *(const f32x4*)(src[u] + 4);
                }
#pragma unroll
                for (int u = 0; u < 4; ++u) { u32x4 o; o.x = cvt_pk(va[u][0], va[u][1]); o.y = cvt_pk(va[u][2], va[u][3]); o.z = cvt_pk(vb[u][0], vb[u][1]); o.w = cvt_pk(vb[u][2], vb[u][3]); *(u32x4*)dst[u] = o; }
            }
        }
    }
    xcd_barrier(xbar);

#ifndef REP2
#define REP2 1
#endif
    for (int rep2 = 0; rep2 < REP2; ++rep2) {
        if (rep2) grid.sync();
        LAS unsigned* misc = (LAS unsigned*)(lds + MISC_OFF);
        constexpr int N_LP = 64, N_LS = 256, N_AS = 128, N_MS = 64, N_GS = 16, N_AP = 2048, N_MPp = 1024;
        constexpr int N_GU = 96, POS_GU = N_LP + N_LS + N_AS + N_MS + N_GS + 1900;
        constexpr int NITEMS = N_LP + N_LS + N_AS + N_MS + N_GS + N_AP + N_MPp + N_GU;
        constexpr unsigned N_SAMPLE_ITEMS = N_LS + N_AS + N_MS;
        for (;;) {
            __syncthreads();
            if (tid == 0) misc[0] = atomicAdd(ctl + CW_QUEUE + 64 * rep2, 1u);
            __syncthreads();
            int it = (int)misc[0];
            if (it >= NITEMS) break;
            bool sample_item = false; bool gs_item = false;
            if (it >= POS_GU && it < POS_GU + N_GU) {
                const int j = it - POS_GU;
                if (tid == 0) { while (__hip_atomic_load(ctl + CW_UDONE, __ATOMIC_RELAXED, __HIP_MEMORY_SCOPE_AGENT) < (unsigned)N_GS) __builtin_amdgcn_s_sleep(8); __threadfence(); }
                __syncthreads();
                pg8::Gemm g{XG, WUP, nullptr, 1 << 20}; pg8::SchedOne S{64 + j / 48, j % 48, 32, nullptr, nullptr};
                pg8::EpiUp E{ssq, args.in[29], args.in[30], args.in[8], out, H, UB, (bf16_t*)(ws + WS_HS)};
                pg8::gemm_phase<pg8::EpiUp, true, pg8::SchedOne, DM>(lds, g, S, E);
                continue;
            }
            if (it >= POS_GU + N_GU) it -= N_GU;
            if (it < N_LP + N_LS) {
                LruArgs a;
                if (it < N_LP) { const int b = it >> 4; a.n = (it >> 1) & 7; a.nb = it & 1; a.Zrow0 = Z + (size_t)b * 4096 * DIN; a.T = 4096; a.conv_past = nullptr; a.h0 = nullptr;
                    a.MIXrow0 = MIX + (size_t)b * 4096 * DM; a.out_bh = out + O_BHP + b * 512; }
                else { const int i2 = it - N_LP, s = i2 >> 4; a.n = (i2 >> 1) & 7; a.nb = i2 & 1; a.Zrow0 = Z + (size_t)(MP + 32 * s) * DIN; a.T = 32; a.conv_past = args.in[6] + (size_t)s * 3 * 512; a.h0 = args.in[7] + (size_t)s * 512;
                    a.MIXrow0 = MIX + (size_t)(MP + 32 * s) * DM; a.out_bh = out + O_BHS + s * 512; sample_item = true; }
                lru_unit(lds, a, args);
            } else if (it >= N_LP + N_LS + N_AS + N_MS && it < N_LP + N_LS + N_AS + N_MS + N_GS) {
                const int j = it - (N_LP + N_LS + N_AS + N_MS);
                if (tid == 0) { while (__hip_atomic_load(ctl + CW_SDONE, __ATOMIC_RELAXED, __HIP_MEMORY_SCOPE_AGENT) < N_SAMPLE_ITEMS) __builtin_amdgcn_s_sleep(8); __threadfence(); }
                __syncthreads();
                pg8::Gemm g{MIX, WOUT, nullptr, 1 << 20}; pg8::SchedOne S{64 + (j >> 3), j & 7, 32, nullptr, nullptr};
                pg8::EpiOut E{x_prompt, x_sample, out + O_Y, XG, args.in[27], ssq};
                pg8::gemm_phase<pg8::EpiOut, false, pg8::SchedOne, DM>(lds, g, S, E);
                gs_item = true;
            } else {
                AttnArgs a;
                if (it < N_LP + N_LS + N_AS) { const int i2 = it - N_LP - N_LS; const int h = i2 & 7, s = i2 >> 3; const int row = MP + 32 * s; sample_item = true;
                    a.Q = Z + (size_t)row * DIN + 128 * h; a.qpitch = DIN; a.nq = 32; a.K = KS + (size_t)s * 544 * 1024 + 128 * h; a.V = VS + (size_t)s * 544 * 1024 + 128 * h; a.kvpitch = 1024;
                    a.ntiles = 17; a.j0 = 0; a.table = args.in[14] + h * 513; a.O = MIX + (size_t)row * DM + 128 * h; a.opitch = DM; }
                else if (it < N_LP + N_LS + N_AS + N_MS) { const int i2 = it - N_LP - N_LS - N_AS; const int hm = i2 & 3, s = i2 >> 2; const int row = MP + 32 * s; sample_item = true;
                    a.Q = Z + (size_t)row * DIN + 3072 + 128 * hm; a.qpitch = DIN; a.nq = 32; a.K = MKS + (size_t)s * 256 * 512 + 128 * hm; a.V = MVS + (size_t)s * 256 * 512 + 128 * hm; a.kvpitch = 512;
                    a.ntiles = 8; a.j0 = 0; a.table = nullptr; a.O = MIX + (size_t)row * DM + 1024 + 128 * hm; a.opitch = DM; }
                else if (it < N_LP + N_LS + N_AS + N_MS + N_GS + N_AP) { const int i2 = it - (N_LP + N_LS + N_AS + N_MS + N_GS); const int h = i2 & 7, c = (i2 >> 3) & 63, b = i2 >> 9; const int row = b * 4096 + 64 * c, cb = c < 8 ? c : 8, krow = row - 64 * cb;
                    a.Q = Z + (size_t)row * DIN + 128 * h; a.qpitch = DIN; a.nq = 64; a.K = Z + (size_t)krow * DIN + 1024 + 128 * h; a.V = Z + (size_t)krow * DIN + 2048 + 128 * h; a.kvpitch = DIN;
                    a.ntiles = 2 * (cb + 1); a.j0 = 512 - 64 * cb; a.table = args.in[14] + h * 513; a.O = MIX + (size_t)row * DM + 128 * h; a.opitch = DM; }
                else { const int i2 = it - (N_LP + N_LS + N_AS + N_MS + N_GS + N_AP); const int hm = i2 & 3, c = (i2 >> 2) & 63, b = i2 >> 8; const int row = b * 4096 + 64 * c;
                    a.Q = Z + (size_t)row * DIN + 3072 + 128 * hm; a.qpitch = DIN; a.nq = 64; a.K = MKP + (size_t)b * 256 * 512 + 128 * hm; a.V = MVP + (size_t)b * 256 * 512 + 128 * hm; a.kvpitch = 512;
                    a.ntiles = 8; a.j0 = 0; a.table = nullptr; a.O = MIX + (size_t)row * DM + 1024 + 128 * hm; a.opitch = DM; }
                attn_unit(lds, a);
            }
            if (sample_item || gs_item) {
                asm volatile("s_waitcnt vmcnt(0)" ::: "memory");
                __syncthreads();
                if (tid == 0) { __threadfence(); __hip_atomic_fetch_add(ctl + (gs_item ? CW_UDONE : CW_SDONE), 1u, __ATOMIC_RELAXED, __HIP_MEMORY_SCOPE_AGENT); }
            }
        }
    }
    xcd_barrier(xbar);

    {
        pg8::Gemm g{MIX, WOUT, nullptr, 1 << 20}; typedef pg8::SchedT<64, 8, 32, 0, 0, 0, 1, 0, 0, 1> S3; S3 S{G, bx, nullptr, nullptr};
        pg8::EpiOut E{x_prompt, x_sample, out + O_Y, XG, args.in[27], ssq};
        pg8::gemm_phase<pg8::EpiOut, false, S3, DM>(lds, g, S, E);
    }
    xcd_barrier(xbar);

    {
        pg8::Gemm g{XG, WUP, nullptr, 1 << 20}; typedef pg8::SchedT<64, 48, 32, 0, 0, 0, 1, 0, 0, 1> S4; S4 S{G, bx, nullptr, nullptr};
        pg8::EpiUp E{ssq, args.in[29], args.in[30], args.in[8], out, H, UB, (bf16_t*)(ws + WS_HS)};
        pg8::gemm_phase<pg8::EpiUp, true, S4, DM>(lds, g, S, E);
    }
    xcd_barrier(xbar);

    {
        const float* cfw = args.in[29]; const float* cfb = args.in[30];
        const int gt = bx * 512 + tid, NGT = G * 512;
        constexpr int NJ = 128 * 2 * (DFF / 4);
        for (int j = gt; j < NJ; j += NGT) {
            const int c4 = j % (DFF / 4), tt = (j / (DFF / 4)) & 1, bnd = j / (2 * (DFF / 4));
            if ((bnd & 31) == 0) continue;
            const int kap = c4 * 4;
            f32x4 yv[2];
#pragma unroll
            for (int bj = 0; bj < 2; ++bj) { const int col = bj * DFF + kap;
                const f32x4 w0 = *(const f32x4*)(cfw + col), w1 = *(const f32x4*)(cfw + DUP + col), w2 = *(const f32x4*)(cfw + 2 * DUP + col), cb = *(const f32x4*)(cfb + col);
                const f32x4 u0 = *(const f32x4*)(UB + ((size_t)(bnd * 4 + tt) * 2 + bj) * DFF + kap), u1 = *(const f32x4*)(UB + ((size_t)(bnd * 4 + tt + 1) * 2 + bj) * DFF + kap),
                            u2 = *(const f32x4*)(UB + ((size_t)(bnd * 4 + tt + 2) * 2 + bj) * DFF + kap);
                yv[bj] = cb + w0 * u0 + w1 * u1 + w2 * u2; }
            u32x2 w; w.x = cvt_pk(gelu_tanh(yv[1][0]) * yv[0][0], gelu_tanh(yv[1][1]) * yv[0][1]); w.y = cvt_pk(gelu_tanh(yv[1][2]) * yv[0][2], gelu_tanh(yv[1][3]) * yv[0][3]);
            *(u32x2*)(H + (size_t)(128 * bnd + tt) * DFF + kap) = w;
        }
    }
    xcd_barrier(xbar);

    {
        pg8::Gemm g{H, WDN, (const bf16_t*)(ws + WS_HS), 64}; typedef pg8::SchedT<64, 8, 96, 0, 0, 0, 1, 16, 64, 8> S5; S5 S{G, bx, (float*)(ws + WS_END), ctl + CW_CNT5};
        pg8::EpiDown E{out + O_Y};
        pg8::gemm_phase<pg8::EpiDown, false, S5, DFF>(lds, g, S, E);
    }
}

extern "C" void kernel_launch(void* const* d_in, const int* in_sizes, int n_in, void* d_out, int out_size, void* d_ws, size_t ws_size, hipStream_t stream) {
    static int grid = 0;
    if (grid == 0) {
        if (n_in != 32 || ws_size < WS_END + 48 * MiB) { fprintf(stderr, "kernel_launch: n_in %d ws %zu (need 32, >= %zu)\n", n_in, ws_size, (size_t)WS_END); grid = -1; return; }
        int dev = 0, cus = 0, per_cu = 0;
        hipGetDevice(&dev); hipDeviceGetAttribute(&cus, hipDeviceAttributeMultiprocessorCount, dev);
        if (hipFuncSetAttribute((const void*)fwd_megakernel, hipFuncAttributeMaxDynamicSharedMemorySize, LDS_BYTES) != hipSuccess) { fprintf(stderr, "kernel_launch: hipFuncSetAttribute failed\n"); grid = -1; return; }
        if (hipOccupancyMaxActiveBlocksPerMultiprocessor(&per_cu, (const void*)fwd_megakernel, 512, LDS_BYTES) != hipSuccess || per_cu < 1) { fprintf(stderr, "kernel_launch: occupancy query says %d\n", per_cu); per_cu = 1; }
        (void)hipGetLastError();
        grid = cus * 1;
    }
    if (grid < 0) return;
    hipMemsetAsync((char*)d_ws + WS_CTL, 0, CTL_BYTES, stream);
    Args a{};
    for (int i = 0; i < 32; ++i) a.in[i] = (const float*)d_in[i];
    a.out = (float*)d_out; a.ws = (unsigned char*)d_ws;
    void* kargs[] = {&a};
    hipError_t e = hipLaunchCooperativeKernel((const void*)fwd_megakernel, dim3(grid), dim3(512), kargs, LDS_BYTES, stream);
    if (e != hipSuccess) fprintf(stderr, "cooperative launch failed: %s (grid %d)\n", hipGetErrorString(e), grid);
}
```
